# Optimizing an MI355X kernel written in HIP

```python
import math
import jax, jax.numpy as jnp
from jax import lax
import numpy as np

D_MODEL = 2048
BATCH = 2
SEQ = 4096
DEPTH = 2

HEAD_DIM = 128
ROPE_THETA = 10000.0
Q_BLK = 128
NSA_HEADS = 8
NSA_KV_HEADS = 2
NSA_GROUP = NSA_HEADS // NSA_KV_HEADS
CMP_LEN = 32
CMP_STRIDE = 16
SEL_LEN = 64
SEL_TOPK = 16
WIN = 512
SEL_FORCE = 1.0e4
SB_HEADS = 8
DIFF_HEADS = 8
LAMBDA_STD = 0.1
N_EVEN = (DEPTH + 1) // 2
N_ODD = DEPTH // 2
DEEPNORM_ALPHA = (2.0 * DEPTH) ** 0.25
DEEPNORM_BETA = (8.0 * DEPTH) ** -0.25
LN_EPS = 1e-5
RMS_EPS = 1e-5
A_Q = NSA_HEADS * HEAD_DIM
A_KV = NSA_KV_HEADS * HEAD_DIM
A_GATES = 3 * NSA_HEADS
B_W = SB_HEADS * HEAD_DIM
EVEN_SIZES = (A_Q, A_KV, A_KV, A_KV, A_KV, A_KV, A_KV, A_GATES, A_Q, B_W, B_W, B_W, B_W)
EVEN_IN = A_Q + 6 * A_KV + A_GATES + A_Q + 4 * B_W
EVEN_OUT = A_Q + B_W
C_W = DIFF_HEADS * 2 * HEAD_DIM
ODD_SIZES = (C_W, C_W, C_W, C_W)
ODD_IN = 4 * C_W
ODD_OUT = C_W

kernel_name = 'hybrid_nsa_stickbreak_diffattn_deepnorm'


def _split(h, sizes):
    offs = np.cumsum(np.array(sizes))[:-1].tolist()
    return jnp.split(h, offs, axis=-1)


def _rope_tables(seq):
    pos = jnp.arange(seq, dtype=jnp.float32)
    inv = ROPE_THETA ** (-jnp.arange(0, HEAD_DIM, 2, dtype=jnp.float32) / HEAD_DIM)
    ang = pos[:, None] * inv[None, :]
    return jnp.cos(ang), jnp.sin(ang)


def _rope(x, cos, sin):
    xf = x.astype(jnp.float32)
    x1, x2 = jnp.split(xf, 2, axis=-1)
    c = cos[None, :, None, :]
    s = sin[None, :, None, :]
    return jnp.concatenate([x1 * c - x2 * s, x2 * c + x1 * s], axis=-1).astype(x.dtype)


def _layer_norm(x, g, b):
    xf = x.astype(jnp.float32)
    mu = jnp.mean(xf, axis=-1, keepdims=True)
    var = jnp.mean(jnp.square(xf - mu), axis=-1, keepdims=True)
    y = (xf - mu) * lax.rsqrt(var + LN_EPS) * g.astype(jnp.float32) + b.astype(jnp.float32)
    return y.astype(x.dtype)


def _masked_softmax(s, mask):
    s = jnp.where(mask, s.astype(jnp.float32), -jnp.inf)
    m = jnp.max(s, axis=-1, keepdims=True)
    m = jnp.where(jnp.isfinite(m), m, 0.0)
    e = jnp.exp(s - m)
    den = jnp.sum(e, axis=-1, keepdims=True)
    return e / jnp.where(den > 0.0, den, 1.0)


def _nsa_compress(kv, pe, w1, w2):
    b, s, hk, d = kv.shape
    n_sub = CMP_LEN // CMP_STRIDE
    chunks = kv.reshape(b, s // CMP_STRIDE, CMP_STRIDE, hk, d)
    n_cmp = s // CMP_STRIDE - n_sub + 1
    blocks = jnp.concatenate([chunks[:, m:m + n_cmp] for m in range(n_sub)], axis=2)
    blocks = blocks + pe[None, None, :, None, :]
    flat = blocks.transpose(0, 1, 3, 2, 4).reshape(b, n_cmp, hk, CMP_LEN * d)
    return jax.nn.silu(flat @ w1) @ w2


def _nsa(q, kc, vc, ks, vs, kw, vw, gates, cos, sin, pe_k, pe_v, w1k, w2k, w1v, w2v):
    b, s = q.shape[0], q.shape[1]
    hk, g, d = NSA_KV_HEADS, NSA_GROUP, HEAD_DIM
    scale = HEAD_DIM ** -0.5
    t = jnp.arange(s)
    k_cmp = _nsa_compress(kc, pe_k, w1k, w2k)
    v_cmp = _nsa_compress(vc, pe_v, w1v, w2v)
    n_cmp = k_cmp.shape[1]
    qg = q.reshape(b, s, hk, g, d)
    sc = jnp.einsum('bthgd,bnhd->bhgtn', qg, k_cmp).astype(jnp.float32) * scale
    blk_end = jnp.arange(n_cmp) * CMP_STRIDE + CMP_LEN - 1
    p_cmp = _masked_softmax(sc, blk_end[None, :] <= t[:, None])
    o_cmp = jnp.einsum('bhgtn,bnhd->bthgd', p_cmp.astype(v_cmp.dtype), v_cmp)
    n_sel_blk = s // SEL_LEN
    c_start = jnp.arange(n_cmp) * CMP_STRIDE
    s_start = jnp.arange(n_sel_blk) * SEL_LEN
    overlap = ((c_start[:, None] < s_start[None, :] + SEL_LEN)
               & (c_start[:, None] + CMP_LEN > s_start[None, :])).astype(jnp.float32)
    imp = jnp.einsum('bhgtn,nj->bhtj', p_cmp, overlap)
    j_cur = t // SEL_LEN
    jj = jnp.arange(n_sel_blk)
    valid = jj[None, :] <= j_cur[:, None]
    forced = (jj[None, :] == 0) | (jj[None, :] == j_cur[:, None]) | (jj[None, :] == j_cur[:, None] - 1)
    score = jnp.where(forced, SEL_FORCE, jnp.where(valid, imp, -SEL_FORCE))
    n_sel = min(SEL_TOPK, n_sel_blk)
    _, idx = lax.top_k(score, n_sel)
    qr = _rope(q, cos, sin).reshape(b, s, hk, g, d).transpose(0, 2, 3, 1, 4)
    ks_b = _rope(ks, cos, sin).transpose(0, 2, 1, 3).reshape(b, hk, n_sel_blk, SEL_LEN, d)
    vs_b = vs.transpose(0, 2, 1, 3).reshape(b, hk, n_sel_blk, SEL_LEN, d)
    pad = ((0, 0), (0, 0), (WIN, 0), (0, 0))
    kw_p = jnp.pad(_rope(kw, cos, sin).transpose(0, 2, 1, 3), pad)
    vw_p = jnp.pad(vw.transpose(0, 2, 1, 3), pad)
    gather = jax.vmap(jax.vmap(lambda tab, ix: tab[ix]))

    def block(i):
        q0 = i * Q_BLK
        tq = q0 + jnp.arange(Q_BLK)
        qb = lax.dynamic_slice_in_dim(qr, q0, Q_BLK, axis=3)
        ib = lax.dynamic_slice_in_dim(idx, q0, Q_BLK, axis=2)
        kg = gather(ks_b, ib)
        vg = gather(vs_b, ib)
        s_sel = jnp.einsum('bhgqd,bhqnjd->bhgqnj', qb, kg).astype(jnp.float32) * scale
        pos = ib[..., None] * SEL_LEN + jnp.arange(SEL_LEN)
        m_sel = (pos <= tq[None, None, :, None, None]).reshape(b, hk, 1, Q_BLK, n_sel * SEL_LEN)
        p_sel = _masked_softmax(s_sel.reshape(b, hk, g, Q_BLK, n_sel * SEL_LEN), m_sel)
        p_sel = p_sel.reshape(b, hk, g, Q_BLK, n_sel, SEL_LEN).astype(vg.dtype)
        o_sel = jnp.einsum('bhgqnj,bhqnjd->bhgqd', p_sel, vg)
        kwb = lax.dynamic_slice_in_dim(kw_p, q0, WIN + Q_BLK, axis=2)
        vwb = lax.dynamic_slice_in_dim(vw_p, q0, WIN + Q_BLK, axis=2)
        spos = q0 - WIN + jnp.arange(WIN + Q_BLK)
        m_w = (spos[None, :] >= 0) & (spos[None, :] <= tq[:, None]) & (tq[:, None] - spos[None, :] < WIN)
        s_w = jnp.einsum('bhgqd,bhkd->bhgqk', qb, kwb).astype(jnp.float32) * scale
        p_w = _masked_softmax(s_w, m_w).astype(vwb.dtype)
        o_w = jnp.einsum('bhgqk,bhkd->bhgqd', p_w, vwb)
        return o_sel, o_w

    o_sel, o_win = lax.map(block, jnp.arange(s // Q_BLK))
    o_sel = o_sel.transpose(1, 0, 4, 2, 3, 5).reshape(b, s, hk, g, d)
    o_win = o_win.transpose(1, 0, 4, 2, 3, 5).reshape(b, s, hk, g, d)
    gt = jax.nn.sigmoid(gates.astype(jnp.float32)).reshape(b, s, hk, g, 3)
    o = gt[..., 0:1] * o_cmp + gt[..., 1:2] * o_sel + gt[..., 2:3] * o_win
    return o.reshape(b, s, hk * g * d).astype(q.dtype)


def _stick_breaking(q, k, v):
    b, s, h, d = q.shape
    scale = HEAD_DIM ** -0.5
    qh = q.transpose(0, 2, 1, 3)
    kh = k.transpose(0, 2, 1, 3)
    vh = v.transpose(0, 2, 1, 3)
    s_idx = jnp.arange(s)

    def block(i):
        q0 = i * Q_BLK
        tq = q0 + jnp.arange(Q_BLK)
        qb = lax.dynamic_slice_in_dim(qh, q0, Q_BLK, axis=2)
        z = jnp.einsum('bhqd,bhkd->bhqk', qb, kh).astype(jnp.float32) * scale
        mask = s_idx[None, :] < tq[:, None]
        log1m = jnp.where(mask, jax.nn.log_sigmoid(-z), 0.0)
        between = lax.cumsum(log1m, axis=3, reverse=True) - log1m
        a = jnp.where(mask, jnp.exp(jax.nn.log_sigmoid(z) + between), 0.0)
        return jnp.einsum('bhqk,bhkd->bhqd', a.astype(vh.dtype), vh)

    o = lax.map(block, jnp.arange(s // Q_BLK))
    return o.transpose(1, 0, 3, 2, 4).reshape(b, s, h * d)


def _diff_attn(q, k, v, lq1, lk1, lq2, lk2, gn_g, lambda_init, cos, sin):
    b, s = q.shape[0], q.shape[1]
    h, d = DIFF_HEADS, HEAD_DIM
    scale = HEAD_DIM ** -0.5
    qh = _rope(q.reshape(b, s, 2 * h, d), cos, sin).reshape(b, s, h, 2, d).transpose(0, 2, 3, 1, 4)
    kh = _rope(k.reshape(b, s, 2 * h, d), cos, sin).reshape(b, s, h, 2, d).transpose(0, 2, 3, 1, 4)
    vh = v.reshape(b, s, h, 2 * d).transpose(0, 2, 1, 3)
    lam = (jnp.exp(jnp.sum(lq1.astype(jnp.float32) * lk1.astype(jnp.float32)))
           - jnp.exp(jnp.sum(lq2.astype(jnp.float32) * lk2.astype(jnp.float32))) + lambda_init)
    s_idx = jnp.arange(s)

    def block(i):
        q0 = i * Q_BLK
        tq = q0 + jnp.arange(Q_BLK)
        qb = lax.dynamic_slice_in_dim(qh, q0, Q_BLK, axis=3)
        sc = jnp.einsum('bhcqd,bhckd->bhcqk', qb, kh).astype(jnp.float32) * scale
        p = _masked_softmax(sc, s_idx[None, :] <= tq[:, None])
        a = p[:, :, 0] - lam * p[:, :, 1]
        return jnp.einsum('bhqk,bhke->bhqe', a.astype(vh.dtype), vh)

    o = lax.map(block, jnp.arange(s // Q_BLK))
    o = o.transpose(1, 0, 3, 2, 4).reshape(b, s, h, 2 * d).astype(jnp.float32)
    o = o * lax.rsqrt(jnp.mean(jnp.square(o), axis=-1, keepdims=True) + RMS_EPS)
    o = o * gn_g.astype(jnp.float32).reshape(h, 2 * d) * (1.0 - lambda_init)
    return o.reshape(b, s, h * 2 * d).astype(q.dtype)


def _even_layer(x, w_in, pe_k, pe_v, w1k, w2k, w1v, w2v, w_out, ln_g, ln_b, cos, sin):
    b, s, _ = x.shape
    hproj = x @ w_in
    (qa, kc, vc, ks, vs, kw, vw, ga, gate_a, qb, kb, vb, gate_b) = _split(hproj, EVEN_SIZES)
    r = lambda t, hh: t.reshape(b, s, hh, HEAD_DIM)
    o_a = _nsa(r(qa, NSA_HEADS), r(kc, NSA_KV_HEADS), r(vc, NSA_KV_HEADS), r(ks, NSA_KV_HEADS),
               r(vs, NSA_KV_HEADS), r(kw, NSA_KV_HEADS), r(vw, NSA_KV_HEADS), ga, cos, sin,
               pe_k, pe_v, w1k, w2k, w1v, w2v) * jax.nn.silu(gate_a)
    o_b = _stick_breaking(r(qb, SB_HEADS), r(kb, SB_HEADS), r(vb, SB_HEADS)) * jax.nn.silu(gate_b)
    y = jnp.concatenate([o_a, o_b], axis=-1) @ w_out
    return _layer_norm(DEEPNORM_ALPHA * x + y, ln_g, ln_b)


def _odd_layer(x, w_in, lq1, lk1, lq2, lk2, gn_g, w_out, ln_g, ln_b, lambda_init, cos, sin):
    q, k, v, gate = _split(x @ w_in, ODD_SIZES)
    o = _diff_attn(q, k, v, lq1, lk1, lq2, lk2, gn_g, lambda_init, cos, sin) * jax.nn.silu(gate)
    return _layer_norm(DEEPNORM_ALPHA * x + o @ w_out, ln_g, ln_b)


def setup_inputs(seed: int = 0) -> dict:
    key = jax.random.key(seed)
    k = jax.random.split(key, 24)
    nrm = lambda kk, shape, sc: jax.random.normal(kk, shape, jnp.float32) * sc
    d = HEAD_DIM
    return {
        'x': nrm(k[0], (BATCH, SEQ, D_MODEL), 1.0),
        'ev_w_in': nrm(k[1], (N_EVEN, D_MODEL, EVEN_IN), D_MODEL ** -0.5),
        'ev_pe_k': nrm(k[2], (N_EVEN, CMP_LEN, d), 0.1),
        'ev_pe_v': nrm(k[3], (N_EVEN, CMP_LEN, d), 0.1),
        'ev_w1_k': nrm(k[4], (N_EVEN, CMP_LEN * d, d), (CMP_LEN * d) ** -0.5),
        'ev_w2_k': nrm(k[5], (N_EVEN, d, d), d ** -0.5),
        'ev_w1_v': nrm(k[6], (N_EVEN, CMP_LEN * d, d), (CMP_LEN * d) ** -0.5),
        'ev_w2_v': nrm(k[7], (N_EVEN, d, d), d ** -0.5),
        'ev_w_out': nrm(k[8], (N_EVEN, EVEN_OUT, D_MODEL), EVEN_OUT ** -0.5 * DEEPNORM_BETA),
        'ev_ln_g': 1.0 + nrm(k[9], (N_EVEN, D_MODEL), 0.02),
        'ev_ln_b': nrm(k[10], (N_EVEN, D_MODEL), 0.02),
        'od_w_in': nrm(k[11], (N_ODD, D_MODEL, ODD_IN), D_MODEL ** -0.5),
        'od_lq1': nrm(k[12], (N_ODD, d), LAMBDA_STD),
        'od_lk1': nrm(k[13], (N_ODD, d), LAMBDA_STD),
        'od_lq2': nrm(k[14], (N_ODD, d), LAMBDA_STD),
        'od_lk2': nrm(k[15], (N_ODD, d), LAMBDA_STD),
        'od_gn_g': 1.0 + nrm(k[16], (N_ODD, DIFF_HEADS * 2 * d), 0.02),
        'od_w_out': nrm(k[17], (N_ODD, ODD_OUT, D_MODEL), ODD_OUT ** -0.5 * DEEPNORM_BETA),
        'od_ln_g': 1.0 + nrm(k[18], (N_ODD, D_MODEL), 0.02),
        'od_ln_b': nrm(k[19], (N_ODD, D_MODEL), 0.02),
    }


def reference(x, ev_w_in, ev_pe_k, ev_pe_v, ev_w1_k, ev_w2_k, ev_w1_v, ev_w2_v, ev_w_out, ev_ln_g, ev_ln_b,
              od_w_in, od_lq1, od_lk1, od_lq2, od_lk2, od_gn_g, od_w_out, od_ln_g, od_ln_b):
    cos, sin = _rope_tables(x.shape[1])
    for layer in range(DEPTH):
        i = layer // 2
        if layer % 2 == 0:
            x = _even_layer(x, ev_w_in[i], ev_pe_k[i], ev_pe_v[i], ev_w1_k[i], ev_w2_k[i], ev_w1_v[i],
                            ev_w2_v[i], ev_w_out[i], ev_ln_g[i], ev_ln_b[i], cos, sin)
        else:
            lambda_init = 0.8 - 0.6 * math.exp(-0.3 * layer)
            x = _odd_layer(x, od_w_in[i], od_lq1[i], od_lk1[i], od_lq2[i], od_lk2[i], od_gn_g[i],
                           od_w_out[i], od_ln_g[i], od_ln_b[i], lambda_init, cos, sin)
    return x
```

```cpp
#include <hip/hip_runtime.h>
#include <hip/hip_cooperative_groups.h>
#include <cstdio>
#include <cstdint>
namespace cg = cooperative_groups;

#define LAS __attribute__((address_space(3)))
#define PG8_LAS LAS
#define DI __device__ __forceinline__
typedef unsigned short bf16_t;
typedef short bf16x8 __attribute__((ext_vector_type(8)));
typedef short s16x4 __attribute__((ext_vector_type(4)));
typedef float f32x2 __attribute__((ext_vector_type(2)));
typedef float f32x4 __attribute__((ext_vector_type(4)));
typedef float f32x16 __attribute__((ext_vector_type(16)));
typedef unsigned u32x2 __attribute__((ext_vector_type(2)));
typedef unsigned u32x4 __attribute__((ext_vector_type(4)));
typedef __bf16 bf16x2v __attribute__((ext_vector_type(2)));

DI int otid() { int t = threadIdx.x; asm volatile("" : "+v"(t)); return t; }
DI unsigned cvt2(float a, float b) { f32x2 v = {a, b}; bf16x2v r = __builtin_convertvector(v, bf16x2v); return __builtin_bit_cast(unsigned, r); }
DI float bf_lo(unsigned u) { return __uint_as_float(u << 16); }
DI float bf_hi(unsigned u) { return __uint_as_float(u & 0xffff0000u); }
DI float silu_f(float x) { return x / (1.0f + __expf(-x)); }
DI float sigmoid_f(float x) { return 1.0f / (1.0f + __expf(-x)); }

constexpr int SEQ = 4096, NTOK = 8192, DM = 2048, N0 = 7936, N1 = 8192, EV_IN = 7704;
constexpr int NB0 = 62, NB1 = 64;
#define HBLK(H, nblk, b, blk) ((H) + ((size_t)((b) * (nblk) + (blk)) * SEQ) * 128)
constexpr size_t MiB = 1u << 20;
constexpr size_t OFF_A = 0, OFF_B = 32 * MiB, OFF_BTO0 = 64 * MiB, OFF_BTO1 = 72 * MiB, OFF_D = 80 * MiB;
constexpr size_t OFF_W1KT = OFF_D, OFF_W1VT = OFF_D + MiB, OFF_COS = OFF_D + 2 * MiB, OFF_SIN = OFF_D + 3 * MiB;
constexpr size_t OFF_W2KT = OFF_D + 4 * MiB, OFF_W2VT = OFF_W2KT + 32768, OFF_KCMP = OFF_W2VT + 32768, OFF_VCMP = OFF_KCMP + 262144;
constexpr size_t OFF_SSQ = OFF_VCMP + 262144, OFF_CNT = OFF_SSQ + 524288;
constexpr size_t OFF_BAR = OFF_CNT + 256;
constexpr size_t OFF_E = 86 * MiB, OFF_QRAW = OFF_E + 126 * MiB, WS_NEED = OFF_E + 142 * MiB;
constexpr float ALPHA = 1.41421356237309515f;
constexpr float LAMBDA_INIT = 0.35550906759f;
constexpr float QK_C = 0.08838834764831845f * 1.4426950408889634f;

#ifndef REP_GEMM
#define REP_GEMM 1
#endif
#ifndef REP_P0
#define REP_P0 1
#endif
#ifndef REP_P2
#define REP_P2 1
#endif
#ifndef REP_LN
#define REP_LN 1
#endif
#ifndef REP_SYNC
#define REP_SYNC 0
#endif
#ifndef REP_P3
#define REP_P3 1
#endif
#ifndef REP_P7
#define REP_P7 1
#endif
struct Params {
  const float *x, *ev_w_in, *ev_pe_k, *ev_pe_v, *ev_w1_k, *ev_w2_k, *ev_w1_v, *ev_w2_v, *ev_w_out, *ev_ln_g, *ev_ln_b;
  const float *od_w_in, *od_lq1, *od_lk1, *od_lq2, *od_lk2, *od_gn_g, *od_w_out, *od_ln_g, *od_ln_b;
  float* out; char* ws;
};

namespace pg8 {
constexpr int BM = 256, BK = 64, HALF = 128, HTB = HALF * BK * 2, STAGE_BYTES = 8 * HTB, NXCD = 8, WGM = 8;
DI int lds_byte(int r, int c) { const int st = (r >> 4) * 2 + (c >> 5), rr = r & 15, cc = c & 31, ob = rr * 64 + cc * 2; return st * 1024 + (ob ^ (((ob >> 9) & 1) << 5)); }
DI void stage_rc(int b, int& R, int& C) { const int st = b / 1024, sb = b % 1024, swz = sb ^ (((sb >> 9) & 1) << 5); R = (st >> 1) * 16 + swz / 64; C = (st & 1) * 32 + (swz % 64) / 2; }
DI int perm32(int rho) { const int n = rho >> 4, i = rho & 15; return 8 * (i >> 2) + 4 * n + (i & 3); }
struct Unit { int pm, pn; };
struct Gemm { const bf16_t* A; const bf16_t* Bt; int M, N, K; };
struct StaticOrder {
    int nM, nN, nwg, G, c;
    DI void init(int M, int N, int G_, int c_) { nM = M / BM; nN = N / BM; nwg = nM * nN; G = G_; c = c_; }
    DI bool next(int i, Unit& u) const {
        const long L = (long)i * G + c; if (L >= nwg) return false;
        int wgid = (int)L; { const int q = nwg / NXCD, r = nwg % NXCD, xcd = wgid % NXCD, off = wgid / NXCD; wgid = (xcd < r ? xcd * (q + 1) : r * (q + 1) + (xcd - r) * q) + off; }
        const int nig = WGM * nN, gid = wgid / nig, fm = gid * WGM, gsz = (nM - fm) < WGM ? (nM - fm) : WGM;
        u.pm = fm + ((wgid % nig) % gsz); u.pn = (wgid % nig) / gsz; return true;
    }
    DI void a_ready(const Unit&) const {}
    DI void done(const Unit&) const {}
};
struct EpiH {
    static constexpr bool PERM = true, AFTER_DRAIN = false;
    bf16_t* H; int ldc; bf16_t* raw; int ldraw; const float* cosT; const float* sinT; unsigned rope_mask_lo; int rope_upto; int raw_upto;
    DI void operator()(const f32x4 (&acc)[2][2][4][2], const Unit& u, int wr, int wc, int fr, int fq) const {
        const int row0 = u.pm * BM + wr * 64 + fr, col0 = u.pn * BM + wc * 32 + 8 * fq;
        const bool rope = (u.pn < rope_upto) || ((rope_mask_lo >> u.pn) & 1u), wraw = u.pn < raw_upto;
#pragma unroll
        for (int ai = 0; ai < 2; ++ai)
#pragma unroll
            for (int m = 0; m < 4; ++m) { const int row = row0 + ai * HALF + m * 16; const int t = row & (SEQ - 1);
#pragma unroll
                for (int bj = 0; bj < 2; ++bj) { f32x4 v0 = acc[ai][bj][m][0], v1 = acc[ai][bj][m][1]; const int col = col0 + bj * HALF;
                    if (wraw) { u32x4 w; w.x = cvt2(v0[0], v0[1]); w.y = cvt2(v0[2], v0[3]); w.z = cvt2(v1[0], v1[1]); w.w = cvt2(v1[2], v1[3]); *(u32x4*)(raw + (size_t)row * ldraw + col) = w; }
                    if (rope) { const int i0 = (col & 127) >> 1; const f32x4 c = *(const f32x4*)(cosT + t * 64 + i0), s = *(const f32x4*)(sinT + t * 64 + i0);
                        f32x4 a0, a1;
                        a0[0] = v0[0] * c[0] - v0[1] * s[0]; a0[1] = v0[1] * c[0] + v0[0] * s[0]; a0[2] = v0[2] * c[1] - v0[3] * s[1]; a0[3] = v0[3] * c[1] + v0[2] * s[1];
                        a1[0] = v1[0] * c[2] - v1[1] * s[2]; a1[1] = v1[1] * c[2] + v1[0] * s[2]; a1[2] = v1[2] * c[3] - v1[3] * s[3]; a1[3] = v1[3] * c[3] + v1[2] * s[3];
                        v0 = a0; v1 = a1; }
                    u32x4 w; w.x = cvt2(v0[0], v0[1]); w.y = cvt2(v0[2], v0[3]); w.z = cvt2(v1[0], v1[1]); w.w = cvt2(v1[2], v1[3]);
                    *(u32x4*)(H + ((size_t)((row >> 12) * ldc + (col >> 7)) * SEQ + t) * 128 + (col & 127)) = w; } }
    }
};
struct EpiRes {
    static constexpr bool PERM = false, AFTER_DRAIN = false;
    float* R; const float* xres; int ldc;
    DI void operator()(const f32x4 (&acc)[2][2][4][2], const Unit& u, int wr, int wc, int fr, int fq) const {
        const int row0 = u.pm * BM + wr * 64 + fr, col0 = u.pn * BM + wc * 32 + 4 * fq;
#pragma unroll
        for (int ai = 0; ai < 2; ++ai)
#pragma unroll
            for (int m = 0; m < 4; ++m) { const size_t off = (size_t)(row0 + ai * HALF + m * 16) * ldc + col0;
#pragma unroll
                for (int bj = 0; bj < 2; ++bj)
#pragma unroll
                    for (int n = 0; n < 2; ++n) { const f32x4 xr = *(const f32x4*)(xres + off + bj * HALF + n * 16); *(f32x4*)(R + off + bj * HALF + n * 16) = acc[ai][bj][m][n] + xr * ALPHA; } }
    }
};
template <class Epi, class Sched>
__device__ __forceinline__ void gemm_phase(PG8_LAS unsigned char* lds, const Gemm g, const Sched& S, const Epi& E) {
    const int tid = otid(), wid = __builtin_amdgcn_readfirstlane(tid >> 6), lane = tid & 63, wr = wid >> 2, wc = wid & 3, fr = lane & 15, fq = lane >> 4;
    const int K = g.K, nt = K / BK;
    unsigned voffA[2], voffB[2];
#pragma unroll
    for (int i = 0; i < 2; ++i) { int R, C; stage_rc(tid * 16 + i * 8192, R, C); const int Rb = Epi::PERM ? ((R & ~31) + perm32(R & 31)) : R;
        voffA[i] = (unsigned)(R * K + C) * 2u; voffB[i] = (unsigned)(Rb * K + C) * 2u; }
    const size_t kstep = (size_t)(BK * 2);
    const size_t hstep = (size_t)HALF * K * 2;
    const size_t tstep = 2 * hstep;
    const unsigned ldsw = (unsigned)wid * 1024u;
    const int aoff = lds_byte(wr * 64 + fr, fq * 8), boff = lds_byte(wc * 32 + fr, fq * 8);
#define PG8_SA(b, h) (((b) * 2 + (h)) * HTB)
#define PG8_SB(b, h) ((4 + (b) * 2 + (h)) * HTB)
#define PG8_STAGE(bufoff, gbase, voff) do { _Pragma("unroll") for (int _i = 0; _i < 2; ++_i) \
        __builtin_amdgcn_global_load_lds((const unsigned*)((const char*)(gbase) + (voff)[_i]), (PG8_LAS unsigned*)(lds + (bufoff) + ldsw + _i * 8192), 16, 0, 0); } while (0)
#define PG8_LDA(dst, b, h) do { _Pragma("unroll") for (int m = 0; m < 4; ++m) _Pragma("unroll") for (int k = 0; k < 2; ++k) dst[m][k] = *(const PG8_LAS bf16x8*)(lds + PG8_SA(b, h) + aoff + m * 2048 + k * 1024); } while (0)
#define PG8_LDB(dst, b, h) do { _Pragma("unroll") for (int n = 0; n < 2; ++n) _Pragma("unroll") for (int k = 0; k < 2; ++k) dst[n][k] = *(const PG8_LAS bf16x8*)(lds + PG8_SB(b, h) + boff + n * 2048 + k * 1024); } while (0)
#define PG8_MMA(ai, bj, At, Bt) do { __builtin_amdgcn_s_setprio(1); _Pragma("unroll") for (int m = 0; m < 4; ++m) _Pragma("unroll") for (int n = 0; n < 2; ++n) _Pragma("unroll") for (int k = 0; k < 2; ++k) \
        acc[ai][bj][m][n] = __builtin_amdgcn_mfma_f32_16x16x32_bf16(Bt[n][k], At[m][k], acc[ai][bj][m][n], 0, 0, 0); __builtin_amdgcn_s_setprio(0); } while (0)
#define PG8_WAIT_V(n) asm volatile("s_waitcnt vmcnt(" #n ")" ::: "memory")
#define PG8_WAIT_L(n) asm volatile("s_waitcnt lgkmcnt(" #n ")" ::: "memory")
#define PG8_BAR __builtin_amdgcn_s_barrier()
#define PG8_SCHED __builtin_amdgcn_sched_barrier(0)
    Unit cur, nxt; int ui = 0;
    if (!S.next(0, cur)) return;
    f32x4 acc[2][2][4][2];
#pragma unroll
    for (int a = 0; a < 2; ++a)
#pragma unroll
        for (int b = 0; b < 2; ++b)
#pragma unroll
            for (int m = 0; m < 4; ++m)
#pragma unroll
                for (int n = 0; n < 2; ++n) acc[a][b][m][n] = (f32x4){0.f, 0.f, 0.f, 0.f};
    bf16x8 At[4][2], B0[2][2], B1[2][2];
    const char* cA = (const char*)g.A + (size_t)cur.pm * tstep; const char* cB = (const char*)g.Bt + (size_t)cur.pn * tstep;
    S.a_ready(cur);
    PG8_STAGE(PG8_SB(0, 0), cB, voffB); PG8_STAGE(PG8_SA(0, 0), cA, voffA); PG8_STAGE(PG8_SB(0, 1), cB + hstep, voffB); PG8_STAGE(PG8_SA(0, 1), cA + hstep, voffA);
    if (wr == 1) PG8_BAR;
    PG8_WAIT_V(4); PG8_BAR;
    PG8_STAGE(PG8_SB(1, 0), cB + kstep, voffB); PG8_STAGE(PG8_SA(1, 0), cA + kstep, voffA); PG8_STAGE(PG8_SB(1, 1), cB + hstep + kstep, voffB);
    PG8_WAIT_V(6); PG8_BAR;
    for (;;) {
        const bool has_next = S.next(ui + 1, nxt);
        const char* nA = has_next ? (const char*)g.A + (size_t)nxt.pm * tstep : cA; const char* nB = has_next ? (const char*)g.Bt + (size_t)nxt.pn * tstep : cB;
        for (int t = 0; t < nt; t += 2) {
            const bool last = (t == nt - 2);
            const char* a1 = cA + (size_t)(t + 1) * kstep;
            const char* a2 = last ? nA : cA + (size_t)(t + 2) * kstep; const char* b2 = last ? nB : cB + (size_t)(t + 2) * kstep;
            const char* a3 = a2 + kstep; const char* b3 = b2 + kstep;
            if (last && has_next) S.a_ready(nxt);
            PG8_LDB(B0, 0, 0); PG8_SCHED; PG8_LDA(At, 0, 0); PG8_STAGE(PG8_SA(1, 1), a1 + hstep, voffA);
            PG8_WAIT_L(8); PG8_BAR; PG8_WAIT_L(0); PG8_MMA(0, 0, At, B0); PG8_BAR; PG8_SCHED;
            PG8_LDB(B1, 0, 1); PG8_STAGE(PG8_SB(0, 0), b2, voffB);
            PG8_BAR; PG8_WAIT_L(0); PG8_MMA(0, 1, At, B1); PG8_BAR;
            PG8_LDA(At, 0, 1); PG8_STAGE(PG8_SA(0, 0), a2, voffA);
            PG8_BAR; PG8_WAIT_L(0); PG8_MMA(1, 0, At, B0); PG8_BAR; PG8_SCHED;
            PG8_STAGE(PG8_SB(0, 1), b2 + hstep, voffB);
            PG8_WAIT_V(6); PG8_BAR; PG8_MMA(1, 1, At, B1); PG8_BAR;
            PG8_LDB(B0, 1, 0); PG8_SCHED; PG8_LDA(At, 1, 0); PG8_STAGE(PG8_SA(0, 1), a2 + hstep, voffA);
            PG8_WAIT_L(8); PG8_BAR; PG8_WAIT_L(0); PG8_MMA(0, 0, At, B0); PG8_BAR; PG8_SCHED;
            PG8_LDB(B1, 1, 1); PG8_STAGE(PG8_SB(1, 0), b3, voffB);
            PG8_BAR; PG8_WAIT_L(0); PG8_MMA(0, 1, At, B1); PG8_BAR;
            PG8_LDA(At, 1, 1); PG8_STAGE(PG8_SA(1, 0), a3, voffA);
            PG8_BAR; PG8_WAIT_L(0); PG8_MMA(1, 0, At, B0); PG8_BAR; PG8_SCHED;
            PG8_STAGE(PG8_SB(1, 1), b3 + hstep, voffB);
            PG8_WAIT_V(6); PG8_BAR; PG8_MMA(1, 1, At, B1); PG8_BAR;
        }
        if constexpr (!Epi::AFTER_DRAIN) { E(acc, cur, wr, wc, fr, fq); S.done(cur); }
        if (!has_next) break;
#pragma unroll
        for (int a = 0; a < 2; ++a)
#pragma unroll
            for (int b = 0; b < 2; ++b)
#pragma unroll
                for (int m = 0; m < 4; ++m)
#pragma unroll
                    for (int n = 0; n < 2; ++n) acc[a][b][m][n] = (f32x4){0.f, 0.f, 0.f, 0.f};
        cur = nxt; cA = nA; cB = nB; ++ui;
    }
    PG8_WAIT_V(0);
    if (wr == 0) PG8_BAR;
    PG8_BAR;
    if constexpr (Epi::AFTER_DRAIN) { E.fused(acc, cur, wr, wc, fr, fq, lds, wid, lane); S.done(cur); }
#undef PG8_SA
#undef PG8_SB
#undef PG8_STAGE
#undef PG8_LDA
#undef PG8_LDB
#undef PG8_MMA
#undef PG8_WAIT_V
#undef PG8_WAIT_L
#undef PG8_BAR
#undef PG8_SCHED
}
}

DI int rope_perm(int n) { const int d = n & 127; return (n & ~127) + (d >> 1) + 64 * (d & 1); }
DI int colmap(int mode, int n) {
  if (mode == 0) return n;
  if (mode == 1) {
    if (n < 2560) { const bool rp = (n < 1024) || (n >= 1536 && n < 1792) || (n >= 2048 && n < 2304); return rp ? rope_perm(n) : n; }
    if (n < 7680) return n + 24;
    if (n < 7704) return n - 7680 + 2560;
    return -1; }
  if (mode == 2) return n < 4096 ? rope_perm(n) : n;
  return rope_perm(n);
}
DI void transpose_tile(const float* __restrict__ W, int ldw, int K, int mode, bf16_t* __restrict__ Bt, int n0, int k0, LAS float* tl  ) {
  const int tid = otid();
  int srcbase = n0, nvalid = 128; bool perm = false;
  if (mode == 1) { perm = (n0 < 1024) || n0 == 1536 || n0 == 1664 || n0 == 2048 || n0 == 2176;
    if (n0 >= 2560) { if (n0 < 7680) srcbase = n0 + 24; else if (n0 == 7680) { srcbase = 2560; nvalid = 24; } else { srcbase = 0; nvalid = 0; } } }
  else if (mode == 2) perm = n0 < 4096;
  else if (mode == 3) perm = true;
  const int c4 = tid & 31, kq = tid >> 5;
  f32x4 v[8];
#pragma unroll
  for (int j = 0; j < 8; ++j) { const int kk = kq + 16 * j;
    if (4 * c4 < nvalid) v[j] = *(const f32x4*)(W + (size_t)(k0 + kk) * ldw + srcbase + 4 * c4); else v[j] = (f32x4){0.f, 0.f, 0.f, 0.f}; }
#pragma unroll
  for (int j = 0; j < 8; ++j) { const int kk = kq + 16 * j;
#pragma unroll
    for (int e = 0; e < 4; ++e) { const int sj = 4 * c4 + e; const int dl = perm ? ((sj < 64) ? 2 * sj : 2 * (sj - 64) + 1) : sj; tl[dl * 129 + kk] = v[j][e]; } }
  __syncthreads();
  const int n2 = tid >> 2, kc = (tid & 3) * 32; const LAS float* r = tl + n2 * 129 + kc;
#pragma unroll
  for (int u = 0; u < 4; ++u) { u32x4 w; w.x = cvt2(r[8 * u], r[8 * u + 1]); w.y = cvt2(r[8 * u + 2], r[8 * u + 3]); w.z = cvt2(r[8 * u + 4], r[8 * u + 5]); w.w = cvt2(r[8 * u + 6], r[8 * u + 7]);
    *(u32x4*)(Bt + (size_t)(n0 + n2) * K + k0 + kc + 8 * u) = w; }
  __syncthreads();
}
DI void tr_matrix(const float* W, int ldw, int K, int N, int mode, bf16_t* Bt, int& base, int bid, int nb, LAS float* tl) {
  const int nk = K / 128, ntile = (N / 128) * nk;
  const int first = (((bid - base) % nb) + nb) % nb;
  for (int i = first; i < ntile; i += nb) { const int nt = i / nk, kt = i - nt * nk; transpose_tile(W, ldw, K, mode, Bt, nt * 128, kt * 128, tl); }
  base += ntile;
}

DI float wave_sum(float v) {
#pragma unroll
  for (int o = 32; o > 0; o >>= 1) v += __shfl_xor(v, o, 64);
  return v;
}
DI void ln_phase(const float* __restrict__ R, const float* __restrict__ g, const float* __restrict__ bta, float* __restrict__ outf, bf16_t* __restrict__ outb) {
  const int tid = otid(), w = tid >> 6, lane = tid & 63;
  f32x4 gv[8], bv[8];
#pragma unroll
  for (int i = 0; i < 8; ++i) { gv[i] = ((const f32x4*)g)[lane + 64 * i]; bv[i] = ((const f32x4*)bta)[lane + 64 * i]; }
  for (int row = blockIdx.x * 8 + w; row < NTOK; row += gridDim.x * 8) {
    const f32x4* rp = (const f32x4*)(R + (size_t)row * DM); f32x4 v[8]; float s = 0.f;
#pragma unroll
    for (int i = 0; i < 8; ++i) { v[i] = rp[lane + 64 * i]; s += (v[i][0] + v[i][1]) + (v[i][2] + v[i][3]); }
    const float mu = wave_sum(s) * (1.0f / DM); float q = 0.f;
#pragma unroll
    for (int i = 0; i < 8; ++i) { v[i] = v[i] - mu; q += (v[i][0] * v[i][0] + v[i][1] * v[i][1]) + (v[i][2] * v[i][2] + v[i][3] * v[i][3]); }
    const float rstd = __builtin_amdgcn_rsqf(wave_sum(q) * (1.0f / DM) + 1e-5f);
#pragma unroll
    for (int i = 0; i < 8; ++i) { const f32x4 y = v[i] * rstd * gv[i] + bv[i]; ((f32x4*)(outf + (size_t)row * DM))[lane + 64 * i] = y;
      if (outb) { u32x2 w2; w2.x = cvt2(y[0], y[1]); w2.y = cvt2(y[2], y[3]); ((u32x2*)(outb + (size_t)row * DM))[lane + 64 * i] = w2; } }
  }
}

#define MFMA32(a, b, c) __builtin_amdgcn_mfma_f32_32x32x16_bf16((a), (b), (c), 0, 0, 0)
DI void compress_block(const Params& p, int cb, LAS char* lds) {
  const int tid = otid(), w = __builtin_amdgcn_readfirstlane(tid >> 6), lane = tid & 63, r32 = lane & 31, hi = lane >> 5;
  const int tensor = cb >> 5, m0 = (cb & 31) * 32, kq = w;
  const bf16_t* H0 = (const bf16_t*)(p.ws + OFF_E);
  const bf16_t* W1T = (const bf16_t*)(p.ws + (tensor ? OFF_W1VT : OFF_W1KT));
  const bf16_t* W2T = (const bf16_t*)(p.ws + (tensor ? OFF_W2VT : OFF_W2KT));
  const float* pe = tensor ? p.ev_pe_v : p.ev_pe_k;
  bf16_t* outp = (bf16_t*)(p.ws + (tensor ? OFF_VCMP : OFF_KCMP));
  const int m = m0 + r32, bh = m >> 8, b = bh >> 1, hk = bh & 1, n = m & 255;
  const int colblk = (tensor ? 10 : 8) + hk;
  const bf16_t* w1r = W1T + (size_t)r32 * 4096 + 8 * hi;
  f32x16 acc[4];
#pragma unroll
  for (int j = 0; j < 4; ++j) for (int i = 0; i < 16; ++i) acc[j][i] = 0.f;
  for (int l = 4 * kq; l < 4 * kq + 4; ++l) {
    int tok = 16 * n + l; tok = tok > SEQ - 1 ? SEQ - 1 : tok;
    const bf16_t* src = HBLK(H0, NB0, b, colblk) + (size_t)tok * 128 + 8 * hi;
    const float* pel = pe + l * 128 + 8 * hi;
#pragma unroll
    for (int s8 = 0; s8 < 8; ++s8) {
      const u32x4 hv = *(const u32x4*)(src + 16 * s8);
      const f32x4 pa = *(const f32x4*)(pel + 16 * s8), pb = *(const f32x4*)(pel + 16 * s8 + 4);
      u32x4 fv; fv.x = cvt2(bf_lo(hv.x) + pa[0], bf_hi(hv.x) + pa[1]); fv.y = cvt2(bf_lo(hv.y) + pa[2], bf_hi(hv.y) + pa[3]);
      fv.z = cvt2(bf_lo(hv.z) + pb[0], bf_hi(hv.z) + pb[1]); fv.w = cvt2(bf_lo(hv.w) + pb[2], bf_hi(hv.w) + pb[3]);
      const bf16x8 bfrag = __builtin_bit_cast(bf16x8, fv);
#pragma unroll
      for (int j = 0; j < 4; ++j) { const bf16x8 af = *(const bf16x8*)(w1r + (size_t)(32 * j) * 4096 + l * 128 + 16 * s8); acc[j] = MFMA32(af, bfrag, acc[j]); }
    }
  }
  LAS bf16_t* hid = (LAS bf16_t*)lds;
  LAS float* red = (LAS float*)(lds + 16384);
  {
    const int slot = kq > 0 ? kq - 1 : 7;
#pragma unroll
    for (int j = 0; j < 4; ++j) { LAS float* r0 = red + ((slot * 4 + j) * 64 + lane) * 16;
#pragma unroll
      for (int q4 = 0; q4 < 4; ++q4) { f32x4 v0 = {acc[j][4 * q4], acc[j][4 * q4 + 1], acc[j][4 * q4 + 2], acc[j][4 * q4 + 3]}; *(LAS f32x4*)(r0 + 4 * q4) = v0; } }
  }
  __syncthreads();
  if (w < 4) { const int j = w;
#pragma unroll
    for (int q4 = 0; q4 < 4; ++q4) { f32x4 s0 = {0.f, 0.f, 0.f, 0.f};
#pragma unroll
      for (int k = 0; k < 7; ++k) { const LAS float* r0 = red + ((k * 4 + j) * 64 + lane) * 16; s0 = s0 + *(const LAS f32x4*)(r0 + 4 * q4); }
      const LAS float* rz = red + ((7 * 4 + j) * 64 + lane) * 16; s0 = s0 + *(const LAS f32x4*)(rz + 4 * q4);
      const int col = 32 * j + 8 * q4 + 4 * hi;
      u32x2 v; v.x = cvt2(silu_f(s0[0]), silu_f(s0[1])); v.y = cvt2(silu_f(s0[2]), silu_f(s0[3])); *(LAS u32x2*)(hid + r32 * 136 + col) = v; }
  }
  __syncthreads();
  if (w < 4) { const int ct = w;
    f32x16 acc2; for (int i = 0; i < 16; ++i) acc2[i] = 0.f;
#pragma unroll
    for (int s = 0; s < 8; ++s) { const bf16x8 afrag = *(const bf16x8*)(W2T + (32 * ct + r32) * 128 + 16 * s + 8 * hi);
      const bf16x8 bfrag = *(LAS bf16x8*)(hid + r32 * 136 + 16 * s + 8 * hi); acc2 = MFMA32(afrag, bfrag, acc2); }
#pragma unroll
    for (int q4 = 0; q4 < 4; ++q4) { const int col = 32 * ct + 8 * q4 + 4 * hi; u32x2 v; v.x = cvt2(acc2[4 * q4], acc2[4 * q4 + 1]); v.y = cvt2(acc2[4 * q4 + 2], acc2[4 * q4 + 3]);
      *(u32x2*)(outp + (size_t)m * 128 + col) = v; }
  }
  __syncthreads();
}

constexpr int KBUF = 16384, VROW = 320, VBUF = 64 * VROW;
constexpr int LDS_K0 = 0, LDS_V0 = 2 * KBUF, LDS_MISC = LDS_V0 + 2 * VBUF;
constexpr int LDS_IMP = LDS_MISC + 256, LDS_MASK = LDS_IMP + 64 * 65 * 4, LDS_Q = LDS_MASK + 512, LDS_ATT_END = LDS_Q + 65536, LDS_XB = LDS_ATT_END;
#define KSWZ(row, colB) ((row) * 256 + ((colB) ^ (((((row) & 7) | ((((row) >> 4) & 1) << 3))) << 4)))
DI int crow(int r, int hi) { return (r & 3) + 8 * (r >> 2) + 4 * hi; }
struct Stage { bf16x8 k0, k1, v0, v1; };
DI void stage_load(int tid, Stage& s, const bf16_t* __restrict__ Kg, int ldk, const bf16_t* __restrict__ Vg, int ldv, int key0) {
  const int row = tid >> 4, d8 = (tid & 15) * 8;
  s.k0 = *(const bf16x8*)(Kg + (size_t)(key0 + row) * ldk + d8); s.k1 = *(const bf16x8*)(Kg + (size_t)(key0 + 32 + row) * ldk + d8);
  s.v0 = *(const bf16x8*)(Vg + (size_t)(key0 + row) * ldv + d8); s.v1 = *(const bf16x8*)(Vg + (size_t)(key0 + 32 + row) * ldv + d8);
}
DI void stage_write(int tid, const Stage& s, LAS char* lds, int buf) {
  const int row = tid >> 4, cb = (tid & 15) * 16;
  *(LAS bf16x8*)(lds + LDS_K0 + buf * KBUF + KSWZ(row, cb)) = s.k0; *(LAS bf16x8*)(lds + LDS_K0 + buf * KBUF + KSWZ(row + 32, cb)) = s.k1;
  *(LAS bf16x8*)(lds + LDS_V0 + buf * VBUF + row * VROW + cb) = s.v0; *(LAS bf16x8*)(lds + LDS_V0 + buf * VBUF + (row + 32) * VROW + cb) = s.v1;
}
DI void load_q(LAS char* qs, const bf16_t* qrow  ) {
#pragma unroll
  for (int d0 = 0; d0 < 8; ++d0) *(LAS bf16x8*)(qs + 1024 * d0) = *(const bf16x8*)(qrow + 16 * d0);
}
DI void qkt(f32x16& p0, f32x16& p1, LAS char* Kb, LAS char* qs, int r32, int hi) {
  for (int i = 0; i < 16; ++i) { p0[i] = 0.f; p1[i] = 0.f; }
#pragma unroll
  for (int d0 = 0; d0 < 8; ++d0) { const int cb = (d0 * 16 + hi * 8) * 2;
    const bf16x8 a0 = *(LAS bf16x8*)(Kb + KSWZ(r32, cb)); const bf16x8 a1 = *(LAS bf16x8*)(Kb + KSWZ(32 + r32, cb));
    const bf16x8 qf = *(LAS bf16x8*)(qs + 1024 * d0);
    p0 = MFMA32(a0, qf, p0); p1 = MFMA32(a1, qf, p1); }
}
DI bf16x8 pack8(const f32x16& p, int base) {
  u32x4 w; w.x = cvt2(p[base], p[base + 1]); w.y = cvt2(p[base + 2], p[base + 3]); w.z = cvt2(p[base + 4], p[base + 5]); w.w = cvt2(p[base + 6], p[base + 7]);
  return __builtin_bit_cast(bf16x8, w);
}
DI void pv(f32x16 (&o)[4], LAS char* Vb, const f32x16& p0, const f32x16& p1, int lane) {
  bf16x8 pf[4]; pf[0] = pack8(p0, 0); pf[1] = pack8(p0, 8); pf[2] = pack8(p1, 0); pf[3] = pack8(p1, 8);
  const int hi = lane >> 5, i16 = lane & 15, q = i16 >> 2, pp = i16 & 3, blk = (lane >> 4) & 1;
  LAS char* vb = Vb + (4 * hi + q) * VROW + (16 * blk + 4 * pp) * 2;
#pragma unroll
  for (int db = 0; db < 4; ++db) {
    __builtin_amdgcn_sched_barrier(0);
#pragma unroll
    for (int s = 0; s < 4; ++s) {
      const s16x4 lo = __builtin_amdgcn_ds_read_tr16_b64_v4i16((LAS s16x4*)(vb + (16 * s) * VROW + 64 * db));
      const s16x4 hh = __builtin_amdgcn_ds_read_tr16_b64_v4i16((LAS s16x4*)(vb + (16 * s + 8) * VROW + 64 * db));
      const bf16x8 vf = __builtin_shufflevector(lo, hh, 0, 1, 2, 3, 4, 5, 6, 7);
      o[db] = MFMA32(vf, pf[s], o[db]);
    }
  }
  __builtin_amdgcn_sched_barrier(0);
}
DI float pair_max(float v) { const auto rr = __builtin_amdgcn_permlane32_swap(__float_as_uint(v), __float_as_uint(v), false, false); return fmaxf(__uint_as_float(rr[0]), __uint_as_float(rr[1])); }
DI float pair_sum(float v) { const auto rr = __builtin_amdgcn_permlane32_swap(__float_as_uint(v), __float_as_uint(v), false, false); return __uint_as_float(rr[0]) + __uint_as_float(rr[1]); }
DI void softmax_tile(f32x16& p0, f32x16& p1, int lo, int hh, bool lane_on, bool elem_mask, float& m_run, float& l_run, f32x16 (&o)[4], int hi) {
  const float NINF = -__builtin_inff();
  if (elem_mask) {
#pragma unroll
    for (int r = 0; r < 16; ++r) { const int kk = crow(r, hi); const bool v0 = kk >= lo && kk <= hh, v1 = (kk + 32) >= lo && (kk + 32) <= hh;
      p0[r] = v0 ? p0[r] : NINF; p1[r] = v1 ? p1[r] : NINF; }
  }
  float pm = fmaxf(p0[0], p1[0]);
#pragma unroll
  for (int r = 1; r < 16; ++r) pm = fmaxf(fmaxf(pm, p0[r]), p1[r]);
  pm = lane_on ? pm : NINF;
  pm = pair_max(pm) * QK_C;
  if (!__all(pm <= m_run + 8.0f)) {
    const float mn = fmaxf(m_run, pm), alpha = __builtin_amdgcn_exp2f(m_run - mn); m_run = mn; l_run *= alpha;
#pragma unroll
    for (int db = 0; db < 4; ++db)
#pragma unroll
      for (int r = 0; r < 16; ++r) o[db][r] *= alpha;
  }
  const float nm = lane_on ? -m_run : NINF;
  float ls = 0.f;
#pragma unroll
  for (int r = 0; r < 16; ++r) { p0[r] = __builtin_amdgcn_exp2f(fmaf(p0[r], QK_C, nm)); ls += p0[r]; }
#pragma unroll
  for (int r = 0; r < 16; ++r) { p1[r] = __builtin_amdgcn_exp2f(fmaf(p1[r], QK_C, nm)); ls += p1[r]; }
  l_run += ls;
}
#define WBAR() do { asm volatile("s_waitcnt lgkmcnt(0)" ::: "memory"); __builtin_amdgcn_s_barrier(); asm volatile("" ::: "memory"); } while (0)
#define FP_COMPUTE(J, BUF) do { \
    const int tile_ = tile0 + (J), key0_ = tile_ * 64; \
    const bool lsel_ = (sel >> tile_) & 1ull; const int lo_ = klo - key0_, hh_ = khi - key0_; \
    const bool on_ = lsel_ && hh_ >= 0 && lo_ <= 63, fullv_ = lo_ <= 0 && hh_ >= 63; \
    f32x16 p0, p1; \
    qkt(p0, p1, lds + LDS_K0 + (BUF) * KBUF, qs, r32, hi); \
    softmax_tile(p0, p1, lo_, hh_, on_, __any(on_ && !fullv_), m_run, l_run, o, hi); \
    pv(o, lds + LDS_V0 + (BUF) * VBUF, p0, p1, lane); \
  } while (0)
DI void flash_pass(int tid, const bf16_t* Kg, int ldk, const bf16_t* Vg, int ldv, int tile0, int ntiles, LAS char* qs,
                   int klo, int khi, unsigned long long sel, f32x16 (&o)[4], float& m_run, float& l_run, LAS char* lds) {
  const int lane = tid & 63, r32 = lane & 31, hi = lane >> 5;
  const int first = tile0 * 64, last = (tile0 + ntiles - 1) * 64;
  Stage sA, sB;
  stage_load(tid, sA, Kg, ldk, Vg, ldv, first); stage_write(tid, sA, lds, 0);
  { const int k = first + 64; stage_load(tid, sA, Kg, ldk, Vg, ldv, k < last ? k : last); }
  { const int k = first + 128; stage_load(tid, sB, Kg, ldk, Vg, ldv, k < last ? k : last); }
  WBAR();
  for (int it = 0; it < ntiles; it += 2) {
    FP_COMPUTE(it, 0);
    stage_write(tid, sA, lds, 1);
    { const int k = first + (it + 3) * 64; stage_load(tid, sA, Kg, ldk, Vg, ldv, k < last ? k : last); }
    WBAR();
    if (it + 1 < ntiles) FP_COMPUTE(it + 1, 1);
    stage_write(tid, sB, lds, 0);
    { const int k = first + (it + 4) * 64; stage_load(tid, sB, Kg, ldk, Vg, ldv, k < last ? k : last); }
    WBAR();
  }
  __syncthreads();
}
constexpr int K2BUF = 8192, V2ROW = 576, V2BUF = 32 * V2ROW, LDS2_K0 = 0, LDS2_V0 = 2 * K2BUF;
struct Stage2 { bf16x8 k0, v0, v1; };
DI void stage2_load(int tid, Stage2& s, const bf16_t* __restrict__ Kg, int ldk, const bf16_t* __restrict__ Vg, int ldv, int key0) {
  s.k0 = *(const bf16x8*)(Kg + (size_t)(key0 + (tid >> 4)) * ldk + (tid & 15) * 8);
  const bf16_t* vp = Vg + (size_t)((tid >> 4) & 1) * SEQ * 128 + (tid & 15) * 8;
  s.v0 = *(const bf16x8*)(vp + (size_t)(key0 + (tid >> 5)) * ldv);
  s.v1 = *(const bf16x8*)(vp + (size_t)(key0 + 16 + (tid >> 5)) * ldv);
}
DI void stage2_write(int tid, const Stage2& s, LAS char* lds, int buf) {
  *(LAS bf16x8*)(lds + LDS2_K0 + buf * K2BUF + KSWZ(tid >> 4, (tid & 15) * 16)) = s.k0;
  *(LAS bf16x8*)(lds + LDS2_V0 + buf * V2BUF + (tid >> 5) * V2ROW + (tid & 31) * 16) = s.v0;
  *(LAS bf16x8*)(lds + LDS2_V0 + buf * V2BUF + (16 + (tid >> 5)) * V2ROW + (tid & 31) * 16) = s.v1;
}
#define F256_COMPUTE(IT, BUF) do { \
    const int hh = t - (IT) * 32; \
    f32x16 p0; for (int i = 0; i < 16; ++i) p0[i] = 0.f; \
    LAS char* Kb = lds + LDS2_K0 + (BUF) * K2BUF; \
    _Pragma("unroll") for (int d0 = 0; d0 < 8; ++d0) { const int cb = (d0 * 16 + hi * 8) * 2; const bf16x8 a0 = *(LAS bf16x8*)(Kb + KSWZ(r32, cb)); const bf16x8 qf = *(LAS bf16x8*)(qs + 1024 * d0); p0 = MFMA32(a0, qf, p0); } \
    if (!__all(hh >= 31)) { _Pragma("unroll") for (int r = 0; r < 16; ++r) p0[r] = crow(r, hi) <= hh ? p0[r] : NINF; } \
    float pm = p0[0]; \
    _Pragma("unroll") for (int r = 1; r < 16; ++r) pm = fmaxf(pm, p0[r]); \
    pm = pair_max(pm) * QK_C; \
    if (!__all(pm <= m_run + 8.0f)) { \
      const float mn = fmaxf(m_run, pm), alpha = __builtin_amdgcn_exp2f(m_run - mn); m_run = mn; l_run *= alpha; \
      _Pragma("unroll") for (int db = 0; db < 8; ++db) _Pragma("unroll") for (int r = 0; r < 16; ++r) o[db][r] *= alpha; } \
    const float nm = -m_run; float ls = 0.f; \
    _Pragma("unroll") for (int r = 0; r < 16; ++r) { p0[r] = __builtin_amdgcn_exp2f(fmaf(p0[r], QK_C, nm)); ls += p0[r]; } \
    l_run += ls; \
    bf16x8 pf[2]; pf[0] = pack8(p0, 0); pf[1] = pack8(p0, 8); \
    LAS char* vb = lds + LDS2_V0 + (BUF) * V2BUF + (4 * hi + q) * V2ROW + (16 * blk + 4 * pp) * 2; \
    _Pragma("unroll") for (int db = 0; db < 8; ++db) { \
      __builtin_amdgcn_sched_barrier(0); \
      _Pragma("unroll") for (int s2 = 0; s2 < 2; ++s2) { \
        const s16x4 lo = __builtin_amdgcn_ds_read_tr16_b64_v4i16((LAS s16x4*)(vb + (16 * s2) * V2ROW + 64 * db)); \
        const s16x4 h2 = __builtin_amdgcn_ds_read_tr16_b64_v4i16((LAS s16x4*)(vb + (16 * s2 + 8) * V2ROW + 64 * db)); \
        const bf16x8 vf = __builtin_shufflevector(lo, h2, 0, 1, 2, 3, 4, 5, 6, 7); \
        o[db] = MFMA32(vf, pf[s2], o[db]); } } \
    __builtin_amdgcn_sched_barrier(0); \
  } while (0)
DI void flash256_pass(int tid, const bf16_t* Kg, int ldk, const bf16_t* Vg, int ldv, int ntiles, LAS char* qs, int t, f32x16 (&o)[8], float& m_run, float& l_run, LAS char* lds) {
  const int lane = tid & 63, r32 = lane & 31, hi = lane >> 5;
  const int i16 = lane & 15, q = i16 >> 2, pp = i16 & 3, blk = (lane >> 4) & 1;
  const float NINF = -__builtin_inff();
  Stage2 sA, sB;
  const int last = (ntiles - 1) * 32;
  stage2_load(tid, sA, Kg, ldk, Vg, ldv, 0); stage2_write(tid, sA, lds, 0);
  stage2_load(tid, sA, Kg, ldk, Vg, ldv, 32);
  stage2_load(tid, sB, Kg, ldk, Vg, ldv, 64);
  WBAR();
  for (int it = 0; it < ntiles; it += 2) {
    F256_COMPUTE(it, 0);
    stage2_write(tid, sA, lds, 1);
    { const int k = (it + 3) * 32; stage2_load(tid, sA, Kg, ldk, Vg, ldv, k < last ? k : last); }
    WBAR();
    F256_COMPUTE(it + 1, 1);
    stage2_write(tid, sB, lds, 0);
    { const int k = (it + 4) * 32; stage2_load(tid, sB, Kg, ldk, Vg, ldv, k < last ? k : last); }
    WBAR();
  }
  __syncthreads();
}
#define LADD(ptr, v) __hip_atomic_fetch_add((ptr), (v), __ATOMIC_RELAXED, __HIP_MEMORY_SCOPE_WORKGROUP)
DI void cmp_importance(int tid, const bf16_t* Kg, int ntiles, LAS char* qs, int khi, float m_fin, float inv_l, int tl, LAS char* lds) {
  const int lane = tid & 63, r32 = lane & 31, hi = lane >> 5;
  LAS int* imp = (LAS int*)(lds + LDS_IMP) + tl * 65;
  const float NINF = -__builtin_inff();
  Stage st;
  stage_load(tid, st, Kg, 128, Kg, 128, 0); stage_write(tid, st, lds, 0); __syncthreads();
  for (int it = 0; it < ntiles; ++it) {
    const int key0 = it * 64, buf = it & 1;
    if (it + 1 < ntiles) stage_load(tid, st, Kg, 128, Kg, 128, key0 + 64);
    const int hh = khi - key0;
    if (__any(hh >= 0)) {
      f32x16 p0, p1; qkt(p0, p1, lds + LDS_K0 + buf * KBUF, qs, r32, hi);
#pragma unroll
      for (int r = 0; r < 16; ++r) { const int kk = crow(r, hi);
        p0[r] = kk <= hh ? __builtin_amdgcn_exp2f(fmaf(p0[r], QK_C, -m_fin)) * inv_l : 0.f;
        p1[r] = (kk + 32) <= hh ? __builtin_amdgcn_exp2f(fmaf(p1[r], QK_C, -m_fin)) * inv_l : 0.f; }
#pragma unroll
      for (int q = 0; q < 4; ++q) {
        const float a0 = (p0[4 * q] + p0[4 * q + 1]) + (p0[4 * q + 2] + p0[4 * q + 3]), a1 = (p1[4 * q] + p1[4 * q + 1]) + (p1[4 * q + 2] + p1[4 * q + 3]);
        const int g0 = 16 * it + 2 * q + hi, g1 = g0 + 8;
        LADD(imp + g0, (int)(a0 * 67108864.0f + 0.5f)); LADD(imp + g1, (int)(a1 * 67108864.0f + 0.5f));
        LADD(imp + g0 + 1, (int)(p0[4 * q + 3] * 67108864.0f + 0.5f));
        if (g1 + 1 < 64) LADD(imp + g1 + 1, (int)(p1[4 * q + 3] * 67108864.0f + 0.5f));
      }
    }
    if (it + 1 < ntiles) stage_write(tid, st, lds, buf ^ 1);
    __syncthreads();
  }
  (void)NINF;
}
DI void sb_pass(int tid, const bf16_t* Kg, int ldk, const bf16_t* Vg, int ldv, int tile_hi, LAS char* qs, int t, f32x16 (&o)[4], LAS char* lds) {
  const int lane = tid & 63, w = __builtin_amdgcn_readfirstlane(tid >> 6), r32 = lane & 31, hi = lane >> 5;
  LAS int* flags = (LAS int*)(lds + LDS_MISC);
  const float NINF = -__builtin_inff();
  float carry = 0.f;
  Stage st;
  stage_load(tid, st, Kg, ldk, Vg, ldv, tile_hi * 64); stage_write(tid, st, lds, 0); __syncthreads();
  for (int it = 0;; ++it) {
    const int tile = tile_hi - it, key0 = tile * 64, buf = it & 1;
    const bool more = tile > 0;
    if (more) stage_load(tid, st, Kg, ldk, Vg, ldv, key0 - 64);
    const int hh = t - 1 - key0;
    if (__any(hh >= 0)) {
      f32x16 p0, p1; qkt(p0, p1, lds + LDS_K0 + buf * KBUF, qs, r32, hi);
      float l0[16], l1[16];
#pragma unroll
      for (int r = 0; r < 16; ++r) { const int kk = crow(r, hi);
        { const float Z = p0[r] * QK_C; const float sp = fmaxf(Z, 0.f) + __builtin_amdgcn_logf(1.0f + __builtin_amdgcn_exp2f(-fabsf(Z))); const bool v = kk <= hh; l0[r] = v ? -sp : 0.f; p0[r] = v ? Z - sp : NINF; }
        { const float Z = p1[r] * QK_C; const float sp = fmaxf(Z, 0.f) + __builtin_amdgcn_logf(1.0f + __builtin_amdgcn_exp2f(-fabsf(Z))); const bool v = (kk + 32) <= hh; l1[r] = v ? -sp : 0.f; p1[r] = v ? Z - sp : NINF; } }
      float run = 0.f;
#pragma unroll
      for (int q = 3; q >= 0; --q) { const float A = (l1[4 * q] + l1[4 * q + 1]) + (l1[4 * q + 2] + l1[4 * q + 3]); const float Ap = __shfl_xor(A, 32, 64);
        const float T = carry + run + (hi == 0 ? Ap : 0.f);
        const float e2 = l1[4 * q + 3], e1 = e2 + l1[4 * q + 2], e0 = e1 + l1[4 * q + 1];
        p1[4 * q + 3] = __builtin_amdgcn_exp2f(p1[4 * q + 3] + T); p1[4 * q + 2] = __builtin_amdgcn_exp2f(p1[4 * q + 2] + T + e2);
        p1[4 * q + 1] = __builtin_amdgcn_exp2f(p1[4 * q + 1] + T + e1); p1[4 * q] = __builtin_amdgcn_exp2f(p1[4 * q] + T + e0);
        run += A + Ap; }
#pragma unroll
      for (int q = 3; q >= 0; --q) { const float A = (l0[4 * q] + l0[4 * q + 1]) + (l0[4 * q + 2] + l0[4 * q + 3]); const float Ap = __shfl_xor(A, 32, 64);
        const float T = carry + run + (hi == 0 ? Ap : 0.f);
        const float e2 = l0[4 * q + 3], e1 = e2 + l0[4 * q + 2], e0 = e1 + l0[4 * q + 1];
        p0[4 * q + 3] = __builtin_amdgcn_exp2f(p0[4 * q + 3] + T); p0[4 * q + 2] = __builtin_amdgcn_exp2f(p0[4 * q + 2] + T + e2);
        p0[4 * q + 1] = __builtin_amdgcn_exp2f(p0[4 * q + 1] + T + e1); p0[4 * q] = __builtin_amdgcn_exp2f(p0[4 * q] + T + e0);
        run += A + Ap; }
      carry += run;
      pv(o, lds + LDS_V0 + buf * VBUF, p0, p1, lane);
    }
    const int wdone = __all(carry < -150.0f) ? 1 : 0;
    if (lane == 0) flags[(it & 1) * 8 + w] = wdone;
    if (more) stage_write(tid, st, lds, buf ^ 1);
    __syncthreads();
    int alld = 1;
#pragma unroll
    for (int i = 0; i < 8; ++i) alld &= flags[(it & 1) * 8 + i];
    if (!more || alld) break;
  }
  __syncthreads();
}

DI int next_item(int* counter, LAS char* lds) {
  LAS int* slot = (LAS int*)(lds + LDS_MISC + 128);
  if (threadIdx.x == 0) *slot = atomicAdd(counter, 1);
  __syncthreads(); const int v = __builtin_amdgcn_readfirstlane(*slot); __syncthreads(); return v;
}
DI void zero_o(f32x16 (&o)[4]) {
#pragma unroll
  for (int db = 0; db < 4; ++db)
#pragma unroll
    for (int r = 0; r < 16; ++r) o[db][r] = 0.f;
}
#define ST_NEXT(ptr) do { (ptr) += 2048; asm volatile("" : "+v"(ptr)); } while (0)
DI void stash_set(float* st, const f32x16 (&o)[4], float sc) {
#pragma unroll
  for (int db = 0; db < 4; ++db)
#pragma unroll
    for (int q4 = 0; q4 < 4; ++q4) { f32x4 v = {o[db][4 * q4] * sc, o[db][4 * q4 + 1] * sc, o[db][4 * q4 + 2] * sc, o[db][4 * q4 + 3] * sc}; *(f32x4*)st = v; ST_NEXT(st); }
}
DI void stash_add(float* st, const f32x16 (&o)[4], float sc) {
#pragma unroll
  for (int db = 0; db < 4; ++db)
#pragma unroll
    for (int q4 = 0; q4 < 4; ++q4) { f32x4 v = *(const f32x4*)st; v[0] += o[db][4 * q4] * sc; v[1] += o[db][4 * q4 + 1] * sc; v[2] += o[db][4 * q4 + 2] * sc; v[3] += o[db][4 * q4 + 3] * sc; *(f32x4*)st = v; ST_NEXT(st); }
}
DI void nsa_item(const Params& p, int item, LAS char* lds, float* stash) {
  const int tid = otid(), w = __builtin_amdgcn_readfirstlane(tid >> 6), lane = tid & 63, r32 = lane & 31, hi = lane >> 5;
  const int jc = 63 - (item >> 2), b = (item >> 1) & 1, hk = item & 1, g = w & 3, qh = w >> 2;
  const int t0 = jc * 64, tl = 32 * qh + r32, t = t0 + tl, head = hk * 4 + g; const size_t row = (size_t)b * SEQ + t;
  const bf16_t* H0 = (const bf16_t*)(p.ws + OFF_E);
  const bf16_t* Qraw = (const bf16_t*)(p.ws + OFF_QRAW);
  const bf16_t* Kc = (const bf16_t*)(p.ws + OFF_KCMP) + (size_t)(b * 2 + hk) * 256 * 128; const bf16_t* Vc = (const bf16_t*)(p.ws + OFF_VCMP) + (size_t)(b * 2 + hk) * 256 * 128;
  bf16_t* Ocat = (bf16_t*)(p.ws + OFF_A);
  float* st = stash + (size_t)blockIdx.x * 32768 + tid * 4;
  const bf16_t* gap = HBLK(H0, NB0, b, 60) + (size_t)t * 128 + head * 3;
  const float g0 = sigmoid_f(bf_lo((unsigned)gap[0])), g1 = sigmoid_f(bf_lo((unsigned)gap[1])), g2 = sigmoid_f(bf_lo((unsigned)gap[2]));
  LAS int* imp = (LAS int*)(lds + LDS_IMP); LAS unsigned* msk = (LAS unsigned*)(lds + LDS_MASK);
  for (int i = tid; i < 64 * 65; i += 512) imp[i] = 0;
  if (tid < 128) msk[tid] = 0u;
  LAS char* qs = lds + LDS_Q + w * 8192 + lane * 16; f32x16 o[4]; float m_run, l_run;
  load_q(qs, Qraw + row * 1024 + head * 128 + 8 * hi);
  const int nmax = t >= 31 ? (t - 31) >> 4 : -1;
  const int ncm = (((t0 + 63 - 31) >> 4) >> 6) + 1;
  zero_o(o); m_run = -1e30f; l_run = 0.f;
  flash_pass(tid, Kc, 128, Vc, 128, 0, ncm, qs, 0, nmax, ~0ull, o, m_run, l_run, lds);
  { const float lt = pair_sum(l_run), inv = lt > 0.f ? 1.0f / lt : 0.f; stash_set(st, o, inv * g0);
    if (jc >= 16) cmp_importance(tid, Kc, ncm, qs, nmax, m_run, inv, tl, lds); }
  unsigned long long sel = ~0ull;
  if (jc >= 16) {
    __syncthreads();
#pragma unroll 1
    for (int qi = 0; qi < 8; ++qi) { const int q = 8 * w + qi, j = lane;
      const bool forced = j == 0 || j == jc || j == jc - 1; const int sc = forced ? 0x7fffffff : (j <= jc ? imp[q * 65 + j] : -1);
      int rank = 0;
#pragma unroll
      for (int j2 = 0; j2 < 64; ++j2) { const int s2 = __builtin_amdgcn_readlane(sc, j2); rank += (s2 > sc || (s2 == sc && j2 < j)) ? 1 : 0; }
      const unsigned long long m = __ballot(rank < 16 && j <= jc);
      if (lane == 0) { msk[2 * q] = (unsigned)m; msk[2 * q + 1] = (unsigned)(m >> 32); } }
    __syncthreads();
    sel = (unsigned long long)msk[2 * tl] | ((unsigned long long)msk[2 * tl + 1] << 32);
  }
  load_q(qs, HBLK(H0, NB0, b, head) + (size_t)t * 128 + 8 * hi);
  zero_o(o); m_run = -1e30f; l_run = 0.f;
  flash_pass(tid, HBLK(H0, NB0, b, 12 + hk), 128, HBLK(H0, NB0, b, 14 + hk), 128, 0, jc + 1, qs, 0, t, sel, o, m_run, l_run, lds);
  { const float lt = pair_sum(l_run), inv = lt > 0.f ? 1.0f / lt : 0.f; stash_add(st, o, inv * g1); }
  const int wt0 = jc >= 8 ? jc - 8 : 0;
  zero_o(o); m_run = -1e30f; l_run = 0.f;
  flash_pass(tid, HBLK(H0, NB0, b, 16 + hk), 128, HBLK(H0, NB0, b, 18 + hk), 128, wt0, jc - wt0 + 1, qs, t - 511, t, ~0ull, o, m_run, l_run, lds);
  { const float lt = pair_sum(l_run), inv = (lt > 0.f ? 1.0f / lt : 0.f) * g2;
    const bf16_t* gate = HBLK(H0, NB0, b, 20 + head) + (size_t)t * 128; bf16_t* dst = Ocat + row * DM + head * 128; const float* stp = st;
#pragma unroll
    for (int db = 0; db < 4; ++db)
#pragma unroll
      for (int q4 = 0; q4 < 4; ++q4) { const int d = 32 * db + 8 * q4 + 4 * hi; const u32x2 gv = *(const u32x2*)(gate + d); float v[4];
        const f32x4 sv = *(const f32x4*)stp; ST_NEXT(stp);
#pragma unroll
        for (int i = 0; i < 4; ++i) v[i] = sv[i] + o[db][4 * q4 + i] * inv;
        u32x2 ov; ov.x = cvt2(v[0] * silu_f(bf_lo(gv.x)), v[1] * silu_f(bf_hi(gv.x))); ov.y = cvt2(v[2] * silu_f(bf_lo(gv.y)), v[3] * silu_f(bf_hi(gv.y)));
        *(u32x2*)(dst + d) = ov; } }
}
DI void sb_item(const Params& p, int idx, LAS char* lds) {
  const int tid = otid(), w = __builtin_amdgcn_readfirstlane(tid >> 6), lane = tid & 63, r32 = lane & 31, hi = lane >> 5;
  const int qb = 15 - (idx >> 4), b = (idx >> 3) & 1, h = idx & 7, t = 256 * qb + 32 * w + r32; const size_t row = (size_t)b * SEQ + t;
  const bf16_t* H0 = (const bf16_t*)(p.ws + OFF_E); bf16_t* Ocat = (bf16_t*)(p.ws + OFF_A);
  LAS char* qs = lds + LDS_Q + w * 8192 + lane * 16; f32x16 o[4]; load_q(qs, HBLK(H0, NB0, b, 28 + h) + (size_t)t * 128 + 8 * hi); zero_o(o);
  sb_pass(tid, HBLK(H0, NB0, b, 36 + h), 128, HBLK(H0, NB0, b, 44 + h), 128, 4 * qb + 3, qs, t, o, lds);
  const bf16_t* gate = HBLK(H0, NB0, b, 52 + h) + (size_t)t * 128; bf16_t* dst = Ocat + row * DM + 1024 + h * 128;
#pragma unroll
  for (int db = 0; db < 4; ++db)
#pragma unroll
    for (int q4 = 0; q4 < 4; ++q4) { const int d = 32 * db + 8 * q4 + 4 * hi; const u32x2 gv = *(const u32x2*)(gate + d);
      u32x2 ov; ov.x = cvt2(o[db][4 * q4] * silu_f(bf_lo(gv.x)), o[db][4 * q4 + 1] * silu_f(bf_hi(gv.x))); ov.y = cvt2(o[db][4 * q4 + 2] * silu_f(bf_lo(gv.y)), o[db][4 * q4 + 3] * silu_f(bf_hi(gv.y)));
      *(u32x2*)(dst + d) = ov; }
}
DI void diff_item(const Params& p, int item, LAS char* lds) {
  const int tid = otid(), w = __builtin_amdgcn_readfirstlane(tid >> 6), lane = tid & 63, r32 = lane & 31, hi = lane >> 5;
  const int qb = 15 - (item >> 5), b = (item >> 4) & 1, h = (item >> 1) & 7, c = item & 1, t = 256 * qb + 32 * w + r32; const size_t row = (size_t)b * SEQ + t;
  const bf16_t* H1 = (const bf16_t*)(p.ws + OFF_E);
  bf16_t* Oc = (bf16_t*)(p.ws + (c ? OFF_B : OFF_A));
  LAS char* qs = lds + LDS_Q + w * 8192 + lane * 16; f32x16 o[8]; float m_run = -1e30f, l_run = 0.f;
#pragma unroll
  for (int db = 0; db < 8; ++db)
#pragma unroll
    for (int r = 0; r < 16; ++r) o[db][r] = 0.f;
  load_q(qs, HBLK(H1, NB1, b, 2 * h + c) + (size_t)t * 128 + 8 * hi);
  flash256_pass(tid, HBLK(H1, NB1, b, 16 + 2 * h + c), 128, HBLK(H1, NB1, b, 32 + 2 * h), 128, 8 * qb + 8, qs, t, o, m_run, l_run, lds);
  const float lt = pair_sum(l_run), inv = lt > 0.f ? 1.0f / lt : 0.f;
  bf16_t* dst = Oc + row * DM + h * 256;
#pragma unroll
  for (int db = 0; db < 8; ++db)
#pragma unroll
    for (int q4 = 0; q4 < 4; ++q4) { const int d = 32 * db + 8 * q4 + 4 * hi;
      u32x2 ov; ov.x = cvt2(o[db][4 * q4] * inv, o[db][4 * q4 + 1] * inv); ov.y = cvt2(o[db][4 * q4 + 2] * inv, o[db][4 * q4 + 3] * inv); *(u32x2*)(dst + d) = ov; }
}

#define XB_TMO      128
#define XB_XCNT(j)  (256  + 64 * (j))
#define XB_XSUB(j)  (1280 + 64 * (j))
#define XB_XGEN(j)  (2304 + 64 * (j))
#define XB_TOP      3328
#define XB_TOPGEN   3392
#define XCD_BAR_WORDS 3456
#define XB_SPIN_CAP (1u << 18)
DI unsigned xb_ld(unsigned* p)              { return __hip_atomic_load(p, __ATOMIC_RELAXED, __HIP_MEMORY_SCOPE_AGENT); }
DI unsigned xb_add(unsigned* p, unsigned v) { return __hip_atomic_fetch_add(p, v, __ATOMIC_RELAXED, __HIP_MEMORY_SCOPE_AGENT); }
DI unsigned xb_xcc_id() { return (unsigned)__builtin_amdgcn_s_getreg((3 << 11) | 20) & 0xFu; }
#define XB_SPIN(cond, bar) do { unsigned _sp = 0; while (cond) { __builtin_amdgcn_s_sleep(1); \
    if ((++_sp & 255u) == 0u) { if (xb_ld(&(bar)[XB_TMO])) break; if (_sp > XB_SPIN_CAP) { atomicAdd(&(bar)[XB_TMO], 1u); break; } } } } while (0)
struct XcdBarrier { unsigned* bar; unsigned x; volatile LAS unsigned* st; };
DI XcdBarrier xcd_barrier_post(unsigned* bar, volatile LAS unsigned* st) {
    XcdBarrier b; b.bar = bar; b.x = xb_xcc_id(); b.st = st;
    if (threadIdx.x == 0) (void)xb_add(&bar[XB_XCNT(b.x)], 1u);
    return b;
}
DI void xcd_barrier_complete(unsigned* bar, unsigned x, unsigned& nloc, unsigned& nx) {
    const unsigned G = gridDim.x * gridDim.y * gridDim.z;
    unsigned sum, cntx, mine, sp = 0u;
    for (;;) {
        sum = 0u; cntx = 0u; mine = 0u;
#pragma unroll
        for (unsigned j = 0; j < 16; ++j) { const unsigned c = xb_ld(&bar[XB_XCNT(j)]); sum += c; cntx += (c > 0u) ? 1u : 0u; mine = (j == x) ? c : mine; }
        if (sum == G) break;
        __builtin_amdgcn_s_sleep(1);
        if ((++sp & 255u) == 0u) { if (xb_ld(&bar[XB_TMO])) break; if (sp > XB_SPIN_CAP) { atomicAdd(&bar[XB_TMO], 1u); break; } }
    }
    nloc = mine > 0u ? mine : 1u; nx = cntx > 0u ? cntx : 1u;
}
DI void xcd_barrier(const XcdBarrier& b) {
    asm volatile("s_waitcnt vmcnt(0)" ::: "memory");
    __syncthreads();
    if (threadIdx.x == 0) {
        unsigned* bar = b.bar;
        __builtin_amdgcn_s_waitcnt(0);
        unsigned nloc = b.st[0], nx = b.st[1];
        if (nloc == 0u) { xcd_barrier_complete(bar, b.x, nloc, nx); b.st[0] = nloc; b.st[1] = nx; }
        const unsigned old = xb_add(&bar[XB_XSUB(b.x)], 1u);
        const unsigned gen = old / nloc;
        if (old + 1u == (gen + 1u) * nloc) {
            __builtin_amdgcn_fence(__ATOMIC_RELEASE, "agent");
            asm volatile("s_waitcnt vmcnt(0)" ::: "memory");
            const unsigned og = xb_add(&bar[XB_TOP], 1u);
            const unsigned tg = og / nx;
            if (og + 1u == (tg + 1u) * nx) xb_add(&bar[XB_TOPGEN], 1u);
            else XB_SPIN(xb_ld(&bar[XB_TOPGEN]) == tg, bar);
            __builtin_amdgcn_fence(__ATOMIC_ACQUIRE, "agent");
            xb_add(&bar[XB_XGEN(b.x)], 1u);
            asm volatile("s_waitcnt vmcnt(0)" ::: "memory");
        } else {
            XB_SPIN(xb_ld(&bar[XB_XGEN(b.x)]) == gen, bar);
            __builtin_amdgcn_fence(__ATOMIC_ACQUIRE, "agent");
            asm volatile("s_waitcnt vmcnt(0)" ::: "memory");
        }
    }
    __syncthreads();
}

__global__ void __launch_bounds__(512) mega(Params p) {
  extern __shared__ __attribute__((aligned(16))) unsigned char shm[];
  LAS char* lds = (LAS char*)shm;
  cg::grid_group grid = cg::this_grid();
  const int bid = blockIdx.x, nb = gridDim.x;
  char* ws = p.ws;
  if (ws == nullptr) grid.sync();
  volatile LAS unsigned* xst = (volatile LAS unsigned*)(lds + LDS_XB);
  if (threadIdx.x == 0) { xst[0] = 0u; xst[1] = 0u; }
  __syncthreads();
  const XcdBarrier xbar = xcd_barrier_post((unsigned*)(ws + OFF_BAR), xst);
#define Xb ((bf16_t*)(ws + OFF_A))
#define cosT ((float*)(ws + OFF_COS))
#define sinT ((float*)(ws + OFF_SIN))
#define cnt ((int*)(ws + OFF_CNT))
#define lamp ((float*)(ws + OFF_CNT + 64))
#define PHASE_IDS int tid = threadIdx.x; asm volatile("" : "+v"(tid)); const size_t gtid = (size_t)bid * 512 + tid, gsz = (size_t)nb * 512; (void)gtid; (void)gsz;

  for (int rep0 = 0; rep0 < REP_P0; ++rep0) { PHASE_IDS
    for (size_t i = gtid; i < (size_t)NTOK * DM / 8; i += gsz) { const f32x4 a = ((const f32x4*)p.x)[2 * i], c = ((const f32x4*)p.x)[2 * i + 1];
      u32x4 w; w.x = cvt2(a[0], a[1]); w.y = cvt2(a[2], a[3]); w.z = cvt2(c[0], c[1]); w.w = cvt2(c[2], c[3]); ((u32x4*)Xb)[i] = w; }
    for (size_t i = gtid; i < (size_t)SEQ * 64; i += gsz) { const int t = (int)(i >> 6), f = (int)(i & 63);
      const float inv = (float)exp2(-(double)f * (13.287712379549449 / 64.0));
      const float ang = (float)t * inv; double rev = (double)ang * 0.15915494309189535; rev -= floor(rev); const float rf = (float)rev;
      cosT[i] = __builtin_amdgcn_cosf(rf); sinT[i] = __builtin_amdgcn_sinf(rf); }
    if (gtid == 0) { for (int i = 0; i < 8; ++i) cnt[i] = 0; float s1 = 0.f, s2 = 0.f; for (int i = 0; i < 128; ++i) { s1 += p.od_lq1[i] * p.od_lk1[i]; s2 += p.od_lq2[i] * p.od_lk2[i]; }
      lamp[0] = __expf(s1) - __expf(s2) + LAMBDA_INIT; }
    int base = 0; LAS float* tl = (LAS float*)lds;
    tr_matrix(p.ev_w_in, EV_IN, DM, N0, 1, (bf16_t*)(ws + OFF_B), base, bid, nb, tl);
    tr_matrix(p.ev_w_out, DM, DM, DM, 0, (bf16_t*)(ws + OFF_BTO0), base, bid, nb, tl);
    tr_matrix(p.ev_w1_k, 128, 4096, 128, 0, (bf16_t*)(ws + OFF_W1KT), base, bid, nb, tl);
    tr_matrix(p.ev_w1_v, 128, 4096, 128, 0, (bf16_t*)(ws + OFF_W1VT), base, bid, nb, tl);
    tr_matrix(p.ev_w2_k, 128, 128, 128, 3, (bf16_t*)(ws + OFF_W2KT), base, bid, nb, tl);
    tr_matrix(p.ev_w2_v, 128, 128, 128, 0, (bf16_t*)(ws + OFF_W2VT), base, bid, nb, tl);
  }
  xcd_barrier(xbar);
  { pg8::Gemm g{Xb, (const bf16_t*)(ws + OFF_B), NTOK, N0, DM}; pg8::StaticOrder S; S.init(NTOK, N0, nb, bid);
    pg8::EpiH E{(bf16_t*)(ws + OFF_E), NB0, (bf16_t*)(ws + OFF_QRAW), 1024, cosT, sinT, (1u << 6) | (1u << 8), 4, 4};
    for (int rep = 0; rep < REP_GEMM; ++rep) pg8::gemm_phase<pg8::EpiH, pg8::StaticOrder>((LAS unsigned char*)shm, g, S, E);
  }
  xcd_barrier(xbar);
  for (int rep2 = 0; rep2 < REP_P2; ++rep2)
  if (bid < 64) compress_block(p, bid, lds);
  xcd_barrier(xbar);
  for (int rep = 0; rep < REP_P3; ++rep) { if (rep) xcd_barrier(xbar);
  for (;;) { const int item = next_item(cnt + 2 * rep, lds); if (item >= 512 + 160) break;
    if (item >= 512) {
      LAS float* tl = (LAS float*)lds;
      for (int u = 0; u < 8; ++u) { const int ti = (item - 512) * 8 + u;
        if (ti < 1024) transpose_tile(p.od_w_in, N1, DM, 2, (bf16_t*)(ws + OFF_B), (ti >> 4) * 128, (ti & 15) * 128, tl);
        else transpose_tile(p.od_w_out, DM, DM, 0, (bf16_t*)(ws + OFF_BTO1), ((ti - 1024) >> 4) * 128, ((ti - 1024) & 15) * 128, tl); }
      continue; }
#ifndef SKIP_NSA
    if (item < 256) nsa_item(p, item, lds, p.out);
#endif
#ifndef SKIP_SB
    if (item >= 256) sb_item(p, item - 256, lds);
#endif
  } }
  xcd_barrier(xbar);
  { pg8::Gemm g{(const bf16_t*)(ws + OFF_A), (const bf16_t*)(ws + OFF_BTO0), NTOK, DM, DM}; pg8::StaticOrder S; S.init(NTOK, DM, nb, bid);
    pg8::EpiRes E{(float*)(ws + OFF_E), p.x, DM};
    for (int rep = 0; rep < REP_GEMM; ++rep) pg8::gemm_phase<pg8::EpiRes, pg8::StaticOrder>((LAS unsigned char*)shm, g, S, E);
  }
  xcd_barrier(xbar);
  for (int r = 0; r < REP_LN; ++r) ln_phase((const float*)(ws + OFF_E), p.ev_ln_g, p.ev_ln_b, p.out, (bf16_t*)(ws + OFF_A));
  for (int r = 0; r < REP_SYNC; ++r) xcd_barrier(xbar);
  xcd_barrier(xbar);
  { pg8::Gemm g{(const bf16_t*)(ws + OFF_A), (const bf16_t*)(ws + OFF_B), NTOK, N1, DM}; pg8::StaticOrder S; S.init(NTOK, N1, nb, bid);
    pg8::EpiH E{(bf16_t*)(ws + OFF_E), NB1, nullptr, 0, cosT, sinT, 0u, 16, 0};
    for (int rep = 0; rep < REP_GEMM; ++rep) pg8::gemm_phase<pg8::EpiH, pg8::StaticOrder>((LAS unsigned char*)shm, g, S, E);
  }
  xcd_barrier(xbar);
  {
    for (int rep = 0; rep < REP_P7; ++rep) { if (rep) xcd_barrier(xbar);
    for (;;) { const int item = next_item(cnt + 1 + 2 * rep, lds); if (item >= 512) break;
#ifndef SKIP_DIFF
      diff_item(p, item, lds);
#endif
    } } }
  xcd_barrier(xbar);
  { const int tid = otid(), w = tid >> 6, lane = tid & 63;
    const float lam = lamp[0];
    bf16_t* O0 = (bf16_t*)(ws + OFF_A); const bf16_t* O1 = (const bf16_t*)(ws + OFF_B); const bf16_t* H1 = (const bf16_t*)(ws + OFF_E);
    for (int pr = bid * 8 + w; pr < NTOK * 8; pr += nb * 8) { const size_t row = (size_t)(pr >> 3); const int h = pr & 7, c0 = h * 256 + 4 * lane;
      const u32x2 a = *(const u32x2*)(O0 + row * DM + c0), bq = *(const u32x2*)(O1 + row * DM + c0), gv = *(const u32x2*)(HBLK(H1, NB1, (int)(row >> 12), 48 + 2 * h + (lane >> 5)) + (size_t)(row & 4095) * 128 + ((4 * lane) & 127));
      const f32x4 gn = *(const f32x4*)(p.od_gn_g + c0);
      float u[4] = {bf_lo(a.x) - lam * bf_lo(bq.x), bf_hi(a.x) - lam * bf_hi(bq.x), bf_lo(a.y) - lam * bf_lo(bq.y), bf_hi(a.y) - lam * bf_hi(bq.y)};
      const float ss = wave_sum((u[0] * u[0] + u[1] * u[1]) + (u[2] * u[2] + u[3] * u[3]));
      const float r = __builtin_amdgcn_rsqf(ss * (1.0f / 256.0f) + 1e-5f) * (1.0f - LAMBDA_INIT);
      u32x2 ov; ov.x = cvt2(u[0] * r * gn[0] * silu_f(bf_lo(gv.x)), u[1] * r * gn[1] * silu_f(bf_hi(gv.x))); ov.y = cvt2(u[2] * r * gn[2] * silu_f(bf_lo(gv.y)), u[3] * r * gn[3] * silu_f(bf_hi(gv.y)));
      *(u32x2*)(O0 + row * DM + c0) = ov; } }
  xcd_barrier(xbar);
  { pg8::Gemm g{(const bf16_t*)(ws + OFF_A), (const bf16_t*)(ws + OFF_BTO1), NTOK, DM, DM}; pg8::StaticOrder S; S.init(NTOK, DM, nb, bid);
    pg8::EpiRes E{(float*)(ws + OFF_E), p.out, DM};
    for (int rep = 0; rep < REP_GEMM; ++rep) pg8::gemm_phase<pg8::EpiRes, pg8::StaticOrder>((LAS unsigned char*)shm, g, S, E);
  }
  xcd_barrier(xbar);
  for (int r = 0; r < REP_LN; ++r) ln_phase((const float*)(ws + OFF_E), p.od_ln_g, p.od_ln_b, p.out, nullptr);
}

extern "C" void kernel_launch(void* const* d_in, const int* in_sizes, int n_in, void* d_out, int out_size, void* d_ws, size_t ws_size, hipStream_t stream) {
  constexpr size_t kDynLds = 156672 + 16;
  static int grid_blocks = 0;
  if (!grid_blocks) {
    int dev = 0, cus = 0, per_cu = 0;
    (void)hipGetDevice(&dev);
    (void)hipDeviceGetAttribute(&cus, hipDeviceAttributeMultiprocessorCount, dev);
    (void)hipFuncSetAttribute((const void*)mega, hipFuncAttributeMaxDynamicSharedMemorySize, (int)kDynLds);
    (void)hipOccupancyMaxActiveBlocksPerMultiprocessor(&per_cu, mega, 512, kDynLds);
    if (per_cu < 1) fprintf(stderr, "occupancy query says 0 blocks per CU\n");
    if (ws_size < WS_NEED) fprintf(stderr, "workspace too small: %zu < %zu\n", ws_size, WS_NEED);
    grid_blocks = cus < 256 ? cus : 256;
  }
  Params p{};
  const float* const* in = (const float* const*)d_in;
  p.x = in[0]; p.ev_w_in = in[1]; p.ev_pe_k = in[2]; p.ev_pe_v = in[3]; p.ev_w1_k = in[4]; p.ev_w2_k = in[5]; p.ev_w1_v = in[6]; p.ev_w2_v = in[7];
  p.ev_w_out = in[8]; p.ev_ln_g = in[9]; p.ev_ln_b = in[10]; p.od_w_in = in[11]; p.od_lq1 = in[12]; p.od_lk1 = in[13]; p.od_lq2 = in[14]; p.od_lk2 = in[15];
  p.od_gn_g = in[16]; p.od_w_out = in[17]; p.od_ln_g = in[18]; p.od_ln_b = in[19]; p.out = (float*)d_out; p.ws = (char*)d_ws;
  (void)hipMemsetAsync((char*)d_ws + OFF_CNT, 0, 256 + XCD_BAR_WORDS * 4, stream);
  void* args[] = {&p};
  hipError_t e = hipLaunchCooperativeKernel((void*)mega, dim3(grid_blocks), dim3(512), args, kDynLds, stream);
  if (e != hipSuccess) fprintf(stderr, "cooperative launch failed: %s (grid %d)\n", hipGetErrorString(e), grid_blocks);
}
```

```cpp
#include <hip/hip_runtime.h>
#include <hip/hip_cooperative_groups.h>
#include <cstdio>
#include <cstdint>
namespace cg = cooperative_groups;

#define LAS __attribute__((address_space(3)))
#define PG8_LAS LAS
#define DI __device__ __forceinline__
typedef unsigned short bf16_t;
typedef short bf16x8 __attribute__((ext_vector_type(8)));
typedef short s16x4 __attribute__((ext_vector_type(4)));
typedef float f32x2 __attribute__((ext_vector_type(2)));
typedef float f32x4 __attribute__((ext_vector_type(4)));
typedef float f32x16 __attribute__((ext_vector_type(16)));
typedef unsigned u32x2 __attribute__((ext_vector_type(2)));
typedef unsigned u32x4 __attribute__((ext_vector_type(4)));
typedef __bf16 bf16x2v __attribute__((ext_vector_type(2)));

DI int otid() { int t = threadIdx.x; asm volatile("" : "+v"(t)); return t; }
DI unsigned cvt2(float a, float b) { f32x2 v = {a, b}; bf16x2v r = __builtin_convertvector(v, bf16x2v); return __builtin_bit_cast(unsigned, r); }
DI float bf_lo(unsigned u) { return __uint_as_float(u << 16); }
DI float bf_hi(unsigned u) { return __uint_as_float(u & 0xffff0000u); }
DI float silu_f(float x) { return x / (1.0f + __expf(-x)); }
DI float sigmoid_f(float x) { return 1.0f / (1.0f + __expf(-x)); }

constexpr int SEQ = 4096, NTOK = 8192, DM = 2048, N0 = 7936, N1 = 8192, EV_IN = 7704;
constexpr int NB0 = 62, NB1 = 64;
#define HBLK(H, nblk, b, blk) ((H) + ((size_t)((b) * (nblk) + (blk)) * SEQ) * 128)
constexpr size_t MiB = 1u << 20;
constexpr size_t OFF_A = 0, OFF_B = 32 * MiB, OFF_BTO0 = 64 * MiB, OFF_BTO1 = 72 * MiB, OFF_D = 80 * MiB;
constexpr size_t OFF_W1KT = OFF_D, OFF_W1VT = OFF_D + MiB, OFF_COS = OFF_D + 2 * MiB, OFF_SIN = OFF_D + 3 * MiB;
constexpr size_t OFF_W2KT = OFF_D + 4 * MiB, OFF_W2VT = OFF_W2KT + 32768, OFF_KCMP = OFF_W2VT + 32768, OFF_VCMP = OFF_KCMP + 262144;
constexpr size_t OFF_SSQ = OFF_VCMP + 262144, OFF_CNT = OFF_SSQ + 524288;
constexpr size_t OFF_BAR = OFF_CNT + 256;
constexpr size_t OFF_E = 86 * MiB, OFF_QRAW = OFF_E + 126 * MiB, WS_NEED = OFF_E + 142 * MiB;
constexpr float ALPHA = 1.41421356237309515f;
constexpr float LAMBDA_INIT = 0.35550906759f;
constexpr float QK_C = 0.08838834764831845f * 1.4426950408889634f;

#ifndef REP_GEMM
#define REP_GEMM 1
#endif
#ifndef REP_P0
#define REP_P0 1
#endif
#ifndef REP_P2
#define REP_P2 1
#endif
#ifndef REP_LN
#define REP_LN 1
#endif
#ifndef REP_SYNC
#define REP_SYNC 0
#endif
#ifndef REP_P3
#define REP_P3 1
#endif
#ifndef REP_P7
#define REP_P7 1
#endif
struct Params {
  const float *x, *ev_w_in, *ev_pe_k, *ev_pe_v, *ev_w1_k, *ev_w2_k, *ev_w1_v, *ev_w2_v, *ev_w_out, *ev_ln_g, *ev_ln_b;
  const float *od_w_in, *od_lq1, *od_lk1, *od_lq2, *od_lk2, *od_gn_g, *od_w_out, *od_ln_g, *od_ln_b;
  float* out; char* ws;
};

namespace pg8 {
constexpr int BM = 256, BK = 64, HALF = 128, HTB = HALF * BK * 2, STAGE_BYTES = 8 * HTB, NXCD = 8, WGM = 8;
DI int lds_byte(int r, int c) { const int st = (r >> 4) * 2 + (c >> 5), rr = r & 15, cc = c & 31, ob = rr * 64 + cc * 2; return st * 1024 + (ob ^ (((ob >> 9) & 1) << 5)); }
DI void stage_rc(int b, int& R, int& C) { const int st = b / 1024, sb = b % 1024, swz = sb ^ (((sb >> 9) & 1) << 5); R = (st >> 1) * 16 + swz / 64; C = (st & 1) * 32 + (swz % 64) / 2; }
DI int perm32(int rho) { const int n = rho >> 4, i = rho & 15; return 8 * (i >> 2) + 4 * n + (i & 3); }
struct Unit { int pm, pn; };
struct Gemm { const bf16_t* A; const bf16_t* Bt; int M, N, K; };
struct StaticOrder {
    int nM, nN, nwg, G, c;
    DI void init(int M, int N, int G_, int c_) { nM = M / BM; nN = N / BM; nwg = nM * nN; G = G_; c = c_; }
    DI bool next(int i, Unit& u) const {
        const long L = (long)i * G + c; if (L >= nwg) return false;
        int wgid = (int)L; { const int q = nwg / NXCD, r = nwg % NXCD, xcd = wgid % NXCD, off = wgid / NXCD; wgid = (xcd < r ? xcd * (q + 1) : r * (q + 1) + (xcd - r) * q) + off; }
        const int nig = WGM * nN, gid = wgid / nig, fm = gid * WGM, gsz = (nM - fm) < WGM ? (nM - fm) : WGM;
        u.pm = fm + ((wgid % nig) % gsz); u.pn = (wgid % nig) / gsz; return true;
    }
    DI void a_ready(const Unit&) const {}
    DI void done(const Unit&) const {}
};
struct EpiH {
    static constexpr bool PERM = true, AFTER_DRAIN = false;
    bf16_t* H; int ldc; bf16_t* raw; int ldraw; const float* cosT; const float* sinT; unsigned rope_mask_lo; int rope_upto; int raw_upto;
    DI void operator()(const f32x4 (&acc)[2][2][4][2], const Unit& u, int wr, int wc, int fr, int fq) const {
        const int row0 = u.pm * BM + wr * 64 + fr, col0 = u.pn * BM + wc * 32 + 8 * fq;
        const bool rope = (u.pn < rope_upto) || ((rope_mask_lo >> u.pn) & 1u), wraw = u.pn < raw_upto;
#pragma unroll
        for (int ai = 0; ai < 2; ++ai)
#pragma unroll
            for (int m = 0; m < 4; ++m) { const int row = row0 + ai * HALF + m * 16; const int t = row & (SEQ - 1);
#pragma unroll
                for (int bj = 0; bj < 2; ++bj) { f32x4 v0 = acc[ai][bj][m][0], v1 = acc[ai][bj][m][1]; const int col = col0 + bj * HALF;
                    if (wraw) { u32x4 w; w.x = cvt2(v0[0], v0[1]); w.y = cvt2(v0[2], v0[3]); w.z = cvt2(v1[0], v1[1]); w.w = cvt2(v1[2], v1[3]); *(u32x4*)(raw + (size_t)row * ldraw + col) = w; }
                    if (rope) { const int i0 = (col & 127) >> 1; const f32x4 c = *(const f32x4*)(cosT + t * 64 + i0), s = *(const f32x4*)(sinT + t * 64 + i0);
                        f32x4 a0, a1;
                        a0[0] = v0[0] * c[0] - v0[1] * s[0]; a0[1] = v0[1] * c[0] + v0[0] * s[0]; a0[2] = v0[2] * c[1] - v0[3] * s[1]; a0[3] = v0[3] * c[1] + v0[2] * s[1];
                        a1[0] = v1[0] * c[2] - v1[1] * s[2]; a1[1] = v1[1] * c[2] + v1[0] * s[2]; a1[2] = v1[2] * c[3] - v1[3] * s[3]; a1[3] = v1[3] * c[3] + v1[2] * s[3];
                        v0 = a0; v1 = a1; }
                    u32x4 w; w.x = cvt2(v0[0], v0[1]); w.y = cvt2(v0[2], v0[3]); w.z = cvt2(v1[0], v1[1]); w.w = cvt2(v1[2], v1[3]);
                    *(u32x4*)(H + ((size_t)((row >> 12) * ldc + (col >> 7)) * SEQ + t) * 128 + (col & 127)) = w; } }
    }
};
struct EpiRes {
    static constexpr bool PERM = false, AFTER_DRAIN = false;
    float* R; const float* xres; int ldc;
    DI void operator()(const f32x4 (&acc)[2][2][4][2], const Unit& u, int wr, int wc, int fr, int fq) const {
        const int row0 = u.pm * BM + wr * 64 + fr, col0 = u.pn * BM + wc * 32 + 4 * fq;
#pragma unroll
        for (int ai = 0; ai < 2; ++ai)
#pragma unroll
            for (int m = 0; m < 4; ++m) { const size_t off = (size_t)(row0 + ai * HALF + m * 16) * ldc + col0;
#pragma unroll
                for (int bj = 0; bj < 2; ++bj)
#pragma unroll
                    for (int n = 0; n < 2; ++n) { const f32x4 xr = *(const f32x4*)(xres + off + bj * HALF + n * 16); *(f32x4*)(R + off + bj * HALF + n * 16) = acc[ai][bj][m][n] + xr * ALPHA; } }
    }
};
struct EpiRes1 {
    static constexpr bool PERM = false, AFTER_DRAIN = false;
    float* R; const float* R0; const float* stat; const float* g; const float* b; int ldc;
    DI void operator()(const f32x4 (&acc)[2][2][4][2], const Unit& u, int wr, int wc, int fr, int fq) const {
        const int row0 = u.pm * BM + wr * 64 + fr, col0 = u.pn * BM + wc * 32 + 4 * fq;
        f32x4 gv[2][2], bv[2][2];
#pragma unroll
        for (int bj = 0; bj < 2; ++bj)
#pragma unroll
            for (int n = 0; n < 2; ++n) { gv[bj][n] = *(const f32x4*)(g + col0 + bj * HALF + n * 16); bv[bj][n] = *(const f32x4*)(b + col0 + bj * HALF + n * 16); }
#pragma unroll
        for (int ai = 0; ai < 2; ++ai)
#pragma unroll
            for (int m = 0; m < 4; ++m) { const int row = row0 + ai * HALF + m * 16; const size_t off = (size_t)row * ldc + col0;
                const f32x2 ms = *(const f32x2*)(stat + 2 * row);
#pragma unroll
                for (int bj = 0; bj < 2; ++bj)
#pragma unroll
                    for (int n = 0; n < 2; ++n) { const f32x4 xr = *(const f32x4*)(R0 + off + bj * HALF + n * 16);
                        const f32x4 x1 = (xr - ms[0]) * ms[1] * gv[bj][n] + bv[bj][n]; *(f32x4*)(R + off + bj * HALF + n * 16) = acc[ai][bj][m][n] + x1 * ALPHA; } }
    }
};
template <class Epi, class Sched>
__device__ __forceinline__ void gemm_phase(PG8_LAS unsigned char* lds, const Gemm g, const Sched& S, const Epi& E) {
    const int tid = otid(), wid = __builtin_amdgcn_readfirstlane(tid >> 6), lane = tid & 63, wr = wid >> 2, wc = wid & 3, fr = lane & 15, fq = lane >> 4;
    const int K = g.K, nt = K / BK;
    unsigned voffA[2], voffB[2];
#pragma unroll
    for (int i = 0; i < 2; ++i) { int R, C; stage_rc(tid * 16 + i * 8192, R, C); const int Rb = Epi::PERM ? ((R & ~31) + perm32(R & 31)) : R;
        voffA[i] = (unsigned)(R * K + C) * 2u; voffB[i] = (unsigned)(Rb * K + C) * 2u; }
    const size_t kstep = (size_t)(BK * 2);
    const size_t hstep = (size_t)HALF * K * 2;
    const size_t tstep = 2 * hstep;
    const unsigned ldsw = (unsigned)wid * 1024u;
    const int aoff = lds_byte(wr * 64 + fr, fq * 8), boff = lds_byte(wc * 32 + fr, fq * 8);
#define PG8_SA(b, h) (((b) * 2 + (h)) * HTB)
#define PG8_SB(b, h) ((4 + (b) * 2 + (h)) * HTB)
#define PG8_STAGE(bufoff, gbase, voff) do { _Pragma("unroll") for (int _i = 0; _i < 2; ++_i) \
        __builtin_amdgcn_global_load_lds((const unsigned*)((const char*)(gbase) + (voff)[_i]), (PG8_LAS unsigned*)(lds + (bufoff) + ldsw + _i * 8192), 16, 0, 0); } while (0)
#define PG8_LDA(dst, b, h) do { _Pragma("unroll") for (int m = 0; m < 4; ++m) _Pragma("unroll") for (int k = 0; k < 2; ++k) dst[m][k] = *(const PG8_LAS bf16x8*)(lds + PG8_SA(b, h) + aoff + m * 2048 + k * 1024); } while (0)
#define PG8_LDB(dst, b, h) do { _Pragma("unroll") for (int n = 0; n < 2; ++n) _Pragma("unroll") for (int k = 0; k < 2; ++k) dst[n][k] = *(const PG8_LAS bf16x8*)(lds + PG8_SB(b, h) + boff + n * 2048 + k * 1024); } while (0)
#define PG8_MMA(ai, bj, At, Bt) do { __builtin_amdgcn_s_setprio(1); _Pragma("unroll") for (int m = 0; m < 4; ++m) _Pragma("unroll") for (int n = 0; n < 2; ++n) _Pragma("unroll") for (int k = 0; k < 2; ++k) \
        acc[ai][bj][m][n] = __builtin_amdgcn_mfma_f32_16x16x32_bf16(Bt[n][k], At[m][k], acc[ai][bj][m][n], 0, 0, 0); __builtin_amdgcn_s_setprio(0); } while (0)
#define PG8_WAIT_V(n) asm volatile("s_waitcnt vmcnt(" #n ")" ::: "memory")
#define PG8_WAIT_L(n) asm volatile("s_waitcnt lgkmcnt(" #n ")" ::: "memory")
#define PG8_BAR __builtin_amdgcn_s_barrier()
#define PG8_SCHED __builtin_amdgcn_sched_barrier(0)
    Unit cur, nxt; int ui = 0;
    if (!S.next(0, cur)) return;
    f32x4 acc[2][2][4][2];
#pragma unroll
    for (int a = 0; a < 2; ++a)
#pragma unroll
        for (int b = 0; b < 2; ++b)
#pragma unroll
            for (int m = 0; m < 4; ++m)
#pragma unroll
                for (int n = 0; n < 2; ++n) acc[a][b][m][n] = (f32x4){0.f, 0.f, 0.f, 0.f};
    bf16x8 At[4][2], B0[2][2], B1[2][2];
    const char* cA = (const char*)g.A + (size_t)cur.pm * tstep; const char* cB = (const char*)g.Bt + (size_t)cur.pn * tstep;
    S.a_ready(cur);
    PG8_STAGE(PG8_SB(0, 0), cB, voffB); PG8_STAGE(PG8_SA(0, 0), cA, voffA); PG8_STAGE(PG8_SB(0, 1), cB + hstep, voffB); PG8_STAGE(PG8_SA(0, 1), cA + hstep, voffA);
    if (wr == 1) PG8_BAR;
    PG8_WAIT_V(4); PG8_BAR;
    PG8_STAGE(PG8_SB(1, 0), cB + kstep, voffB); PG8_STAGE(PG8_SA(1, 0), cA + kstep, voffA); PG8_STAGE(PG8_SB(1, 1), cB + hstep + kstep, voffB);
    PG8_WAIT_V(6); PG8_BAR;
    for (;;) {
        const bool has_next = S.next(ui + 1, nxt);
        const char* nA = has_next ? (const char*)g.A + (size_t)nxt.pm * tstep : cA; const char* nB = has_next ? (const char*)g.Bt + (size_t)nxt.pn * tstep : cB;
        for (int t = 0; t < nt; t += 2) {
            const bool last = (t == nt - 2);
            const char* a1 = cA + (size_t)(t + 1) * kstep;
            const char* a2 = last ? nA : cA + (size_t)(t + 2) * kstep; const char* b2 = last ? nB : cB + (size_t)(t + 2) * kstep;
            const char* a3 = a2 + kstep; const char* b3 = b2 + kstep;
            if (last && has_next) S.a_ready(nxt);
            PG8_LDB(B0, 0, 0); PG8_SCHED; PG8_LDA(At, 0, 0); PG8_STAGE(PG8_SA(1, 1), a1 + hstep, voffA);
            PG8_WAIT_L(8); PG8_BAR; PG8_WAIT_L(0); PG8_MMA(0, 0, At, B0); PG8_BAR; PG8_SCHED;
            PG8_LDB(B1, 0, 1); PG8_STAGE(PG8_SB(0, 0), b2, voffB);
            PG8_BAR; PG8_WAIT_L(0); PG8_MMA(0, 1, At, B1); PG8_BAR;
            PG8_LDA(At, 0, 1); PG8_STAGE(PG8_SA(0, 0), a2, voffA);
            PG8_BAR; PG8_WAIT_L(0); PG8_MMA(1, 0, At, B0); PG8_BAR; PG8_SCHED;
            PG8_STAGE(PG8_SB(0, 1), b2 + hstep, voffB);
            PG8_WAIT_V(6); PG8_BAR; PG8_MMA(1, 1, At, B1); PG8_BAR;
            PG8_LDB(B0, 1, 0); PG8_SCHED; PG8_LDA(At, 1, 0); PG8_STAGE(PG8_SA(0, 1), a2 + hstep, voffA);
            PG8_WAIT_L(8); PG8_BAR; PG8_WAIT_L(0); PG8_MMA(0, 0, At, B0); PG8_BAR; PG8_SCHED;
            PG8_LDB(B1, 1, 1); PG8_STAGE(PG8_SB(1, 0), b3, voffB);
            PG8_BAR; PG8_WAIT_L(0); PG8_MMA(0, 1, At, B1); PG8_BAR;
            PG8_LDA(At, 1, 1); PG8_STAGE(PG8_SA(1, 0), a3, voffA);
            PG8_BAR; PG8_WAIT_L(0); PG8_MMA(1, 0, At, B0); PG8_BAR; PG8_SCHED;
            PG8_STAGE(PG8_SB(1, 1), b3 + hstep, voffB);
            PG8_WAIT_V(6); PG8_BAR; PG8_MMA(1, 1, At, B1); PG8_BAR;
        }
        if constexpr (!Epi::AFTER_DRAIN) { E(acc, cur, wr, wc, fr, fq); S.done(cur); }
        if (!has_next) break;
#pragma unroll
        for (int a = 0; a < 2; ++a)
#pragma unroll
            for (int b = 0; b < 2; ++b)
#pragma unroll
                for (int m = 0; m < 4; ++m)
#pragma unroll
                    for (int n = 0; n < 2; ++n) acc[a][b][m][n] = (f32x4){0.f, 0.f, 0.f, 0.f};
        cur = nxt; cA = nA; cB = nB; ++ui;
    }
    PG8_WAIT_V(0);
    if (wr == 0) PG8_BAR;
    PG8_BAR;
    if constexpr (Epi::AFTER_DRAIN) { E.fused(acc, cur, wr, wc, fr, fq, lds, wid, lane); S.done(cur); }
#undef PG8_SA
#undef PG8_SB
#undef PG8_STAGE
#undef PG8_LDA
#undef PG8_LDB
#undef PG8_MMA
#undef PG8_WAIT_V
#undef PG8_WAIT_L
#undef PG8_BAR
#undef PG8_SCHED
}
}

DI int rope_perm(int n) { const int d = n & 127; return (n & ~127) + (d >> 1) + 64 * (d & 1); }
DI int colmap(int mode, int n) {
  if (mode == 0) return n;
  if (mode == 1) {
    if (n < 2560) { const bool rp = (n < 1024) || (n >= 1536 && n < 1792) || (n >= 2048 && n < 2304); return rp ? rope_perm(n) : n; }
    if (n < 7680) return n + 24;
    if (n < 7704) return n - 7680 + 2560;
    return -1; }
  if (mode == 2) return n < 4096 ? rope_perm(n) : n;
  return rope_perm(n);
}
DI void transpose_tile(const float* __restrict__ W, int ldw, int K, int mode, bf16_t* __restrict__ Bt, int n0, int k0, LAS float* tl  ) {
  const int tid = otid();
  int srcbase = n0, nvalid = 128; bool perm = false;
  if (mode == 1) { perm = (n0 < 1024) || n0 == 1536 || n0 == 1664 || n0 == 2048 || n0 == 2176;
    if (n0 >= 2560) { if (n0 < 7680) srcbase = n0 + 24; else if (n0 == 7680) { srcbase = 2560; nvalid = 24; } else { srcbase = 0; nvalid = 0; } } }
  else if (mode == 2) perm = n0 < 4096;
  else if (mode == 3) perm = true;
  const int c4 = tid & 31, kq = tid >> 5;
  f32x4 v[8];
#pragma unroll
  for (int j = 0; j < 8; ++j) { const int kk = kq + 16 * j;
    if (4 * c4 < nvalid) v[j] = *(const f32x4*)(W + (size_t)(k0 + kk) * ldw + srcbase + 4 * c4); else v[j] = (f32x4){0.f, 0.f, 0.f, 0.f}; }
#pragma unroll
  for (int j = 0; j < 8; ++j) { const int kk = kq + 16 * j;
#pragma unroll
    for (int e = 0; e < 4; ++e) { const int sj = 4 * c4 + e; const int dl = perm ? ((sj < 64) ? 2 * sj : 2 * (sj - 64) + 1) : sj; tl[dl * 129 + kk] = v[j][e]; } }
  __syncthreads();
  const int n2 = tid >> 2, kc = (tid & 3) * 32; const LAS float* r = tl + n2 * 129 + kc;
#pragma unroll
  for (int u = 0; u < 4; ++u) { u32x4 w; w.x = cvt2(r[8 * u], r[8 * u + 1]); w.y = cvt2(r[8 * u + 2], r[8 * u + 3]); w.z = cvt2(r[8 * u + 4], r[8 * u + 5]); w.w = cvt2(r[8 * u + 6], r[8 * u + 7]);
    *(u32x4*)(Bt + (size_t)(n0 + n2) * K + k0 + kc + 8 * u) = w; }
  __syncthreads();
}
DI void tr_matrix(const float* W, int ldw, int K, int N, int mode, bf16_t* Bt, int& base, int bid, int nb, LAS float* tl) {
  const int nk = K / 128, ntile = (N / 128) * nk;
  const int first = (((bid - base) % nb) + nb) % nb;
  for (int i = first; i < ntile; i += nb) { const int nt = i / nk, kt = i - nt * nk; transpose_tile(W, ldw, K, mode, Bt, nt * 128, kt * 128, tl); }
  base += ntile;
}

DI float wave_sum(float v) {
#pragma unroll
  for (int o = 32; o > 0; o >>= 1) v += __shfl_xor(v, o, 64);
  return v;
}
DI void ln_phase(const float* __restrict__ R, const float* __restrict__ g, const float* __restrict__ bta, float* __restrict__ outf, bf16_t* __restrict__ outb, float* __restrict__ stat) {
  const int tid = otid(), w = tid >> 6, lane = tid & 63;
  f32x4 gv[8], bv[8];
#pragma unroll
  for (int i = 0; i < 8; ++i) { gv[i] = ((const f32x4*)g)[lane + 64 * i]; bv[i] = ((const f32x4*)bta)[lane + 64 * i]; }
  for (int row = blockIdx.x * 8 + w; row < NTOK; row += gridDim.x * 8) {
    const f32x4* rp = (const f32x4*)(R + (size_t)row * DM); f32x4 v[8]; float s = 0.f;
#pragma unroll
    for (int i = 0; i < 8; ++i) { v[i] = rp[lane + 64 * i]; s += (v[i][0] + v[i][1]) + (v[i][2] + v[i][3]); }
    const float mu = wave_sum(s) * (1.0f / DM); float q = 0.f;
#pragma unroll
    for (int i = 0; i < 8; ++i) { v[i] = v[i] - mu; q += (v[i][0] * v[i][0] + v[i][1] * v[i][1]) + (v[i][2] * v[i][2] + v[i][3] * v[i][3]); }
    const float rstd = __builtin_amdgcn_rsqf(wave_sum(q) * (1.0f / DM) + 1e-5f);
    if (stat && lane == 0) { f32x2 ms = {mu, rstd}; *(f32x2*)(stat + 2 * row) = ms; }
#pragma unroll
    for (int i = 0; i < 8; ++i) { const f32x4 y = v[i] * rstd * gv[i] + bv[i]; if (outf) ((f32x4*)(outf + (size_t)row * DM))[lane + 64 * i] = y;
      if (outb) { u32x2 w2; w2.x = cvt2(y[0], y[1]); w2.y = cvt2(y[2], y[3]); ((u32x2*)(outb + (size_t)row * DM))[lane + 64 * i] = w2; } }
  }
}

#define MFMA32(a, b, c) __builtin_amdgcn_mfma_f32_32x32x16_bf16((a), (b), (c), 0, 0, 0)
DI void compress_block(const Params& p, int cb, LAS char* lds) {
  const int tid = otid(), w = __builtin_amdgcn_readfirstlane(tid >> 6), lane = tid & 63, r32 = lane & 31, hi = lane >> 5;
  const int tensor = cb >> 5, m0 = (cb & 31) * 32, kq = w;
  const bf16_t* H0 = (const bf16_t*)(p.ws + OFF_E);
  const bf16_t* W1T = (const bf16_t*)(p.ws + (tensor ? OFF_W1VT : OFF_W1KT));
  const bf16_t* W2T = (const bf16_t*)(p.ws + (tensor ? OFF_W2VT : OFF_W2KT));
  const float* pe = tensor ? p.ev_pe_v : p.ev_pe_k;
  bf16_t* outp = (bf16_t*)(p.ws + (tensor ? OFF_VCMP : OFF_KCMP));
  const int m = m0 + r32, bh = m >> 8, b = bh >> 1, hk = bh & 1, n = m & 255;
  const int colblk = (tensor ? 10 : 8) + hk;
  const bf16_t* w1r = W1T + (size_t)r32 * 4096 + 8 * hi;
  f32x16 acc[4];
#pragma unroll
  for (int j = 0; j < 4; ++j) for (int i = 0; i < 16; ++i) acc[j][i] = 0.f;
  for (int l = 4 * kq; l < 4 * kq + 4; ++l) {
    int tok = 16 * n + l; tok = tok > SEQ - 1 ? SEQ - 1 : tok;
    const bf16_t* src = HBLK(H0, NB0, b, colblk) + (size_t)tok * 128 + 8 * hi;
    const float* pel = pe + l * 128 + 8 * hi;
#pragma unroll
    for (int s8 = 0; s8 < 8; ++s8) {
      const u32x4 hv = *(const u32x4*)(src + 16 * s8);
      const f32x4 pa = *(const f32x4*)(pel + 16 * s8), pb = *(const f32x4*)(pel + 16 * s8 + 4);
      u32x4 fv; fv.x = cvt2(bf_lo(hv.x) + pa[0], bf_hi(hv.x) + pa[1]); fv.y = cvt2(bf_lo(hv.y) + pa[2], bf_hi(hv.y) + pa[3]);
      fv.z = cvt2(bf_lo(hv.z) + pb[0], bf_hi(hv.z) + pb[1]); fv.w = cvt2(bf_lo(hv.w) + pb[2], bf_hi(hv.w) + pb[3]);
      const bf16x8 bfrag = __builtin_bit_cast(bf16x8, fv);
#pragma unroll
      for (int j = 0; j < 4; ++j) { const bf16x8 af = *(const bf16x8*)(w1r + (size_t)(32 * j) * 4096 + l * 128 + 16 * s8); acc[j] = MFMA32(af, bfrag, acc[j]); }
    }
  }
  LAS bf16_t* hid = (LAS bf16_t*)lds;
  LAS float* red = (LAS float*)(lds + 16384);
  {
    const int slot = kq > 0 ? kq - 1 : 7;
#pragma unroll
    for (int j = 0; j < 4; ++j) { LAS float* r0 = red + ((slot * 4 + j) * 64 + lane) * 16;
#pragma unroll
      for (int q4 = 0; q4 < 4; ++q4) { f32x4 v0 = {acc[j][4 * q4], acc[j][4 * q4 + 1], acc[j][4 * q4 + 2], acc[j][4 * q4 + 3]}; *(LAS f32x4*)(r0 + 4 * q4) = v0; } }
  }
  __syncthreads();
  if (w < 4) { const int j = w;
#pragma unroll
    for (int q4 = 0; q4 < 4; ++q4) { f32x4 s0 = {0.f, 0.f, 0.f, 0.f};
#pragma unroll
      for (int k = 0; k < 7; ++k) { const LAS float* r0 = red + ((k * 4 + j) * 64 + lane) * 16; s0 = s0 + *(const LAS f32x4*)(r0 + 4 * q4); }
      const LAS float* rz = red + ((7 * 4 + j) * 64 + lane) * 16; s0 = s0 + *(const LAS f32x4*)(rz + 4 * q4);
      const int col = 32 * j + 8 * q4 + 4 * hi;
      u32x2 v; v.x = cvt2(silu_f(s0[0]), silu_f(s0[1])); v.y = cvt2(silu_f(s0[2]), silu_f(s0[3])); *(LAS u32x2*)(hid + r32 * 136 + col) = v; }
  }
  __syncthreads();
  if (w < 4) { const int ct = w;
    f32x16 acc2; for (int i = 0; i < 16; ++i) acc2[i] = 0.f;
#pragma unroll
    for (int s = 0; s < 8; ++s) { const bf16x8 afrag = *(const bf16x8*)(W2T + (32 * ct + r32) * 128 + 16 * s + 8 * hi);
      const bf16x8 bfrag = *(LAS bf16x8*)(hid + r32 * 136 + 16 * s + 8 * hi); acc2 = MFMA32(afrag, bfrag, acc2); }
#pragma unroll
    for (int q4 = 0; q4 < 4; ++q4) { const int col = 32 * ct + 8 * q4 + 4 * hi; u32x2 v; v.x = cvt2(acc2[4 * q4], acc2[4 * q4 + 1]); v.y = cvt2(acc2[4 * q4 + 2], acc2[4 * q4 + 3]);
      *(u32x2*)(outp + (size_t)m * 128 + col) = v; }
  }
  __syncthreads();
}

constexpr int KBUF = 16384, VROW = 320, VBUF = 64 * VROW;
constexpr int LDS_K0 = 0, LDS_V0 = 2 * KBUF, LDS_MISC = LDS_V0 + 2 * VBUF;
constexpr int LDS_IMP = LDS_MISC + 256, LDS_MASK = LDS_IMP + 64 * 65 * 4, LDS_Q = LDS_MASK + 512, LDS_ATT_END = LDS_Q + 65536, LDS_XB = LDS_ATT_END;
#define KSWZ(row, colB) ((row) * 256 + ((colB) ^ (((((row) & 7) | ((((row) >> 4) & 1) << 3))) << 4)))
DI int crow(int r, int hi) { return (r & 3) + 8 * (r >> 2) + 4 * hi; }
struct Stage { bf16x8 k0, k1, v0, v1; };
DI void stage_load(int tid, Stage& s, const bf16_t* __restrict__ Kg, int ldk, const bf16_t* __restrict__ Vg, int ldv, int key0) {
  const int row = tid >> 4, d8 = (tid & 15) * 8;
  s.k0 = *(const bf16x8*)(Kg + (size_t)(key0 + row) * ldk + d8); s.k1 = *(const bf16x8*)(Kg + (size_t)(key0 + 32 + row) * ldk + d8);
  s.v0 = *(const bf16x8*)(Vg + (size_t)(key0 + row) * ldv + d8); s.v1 = *(const bf16x8*)(Vg + (size_t)(key0 + 32 + row) * ldv + d8);
}
DI void stage_write(int tid, const Stage& s, LAS char* lds, int buf) {
  const int row = tid >> 4, cb = (tid & 15) * 16;
  *(LAS bf16x8*)(lds + LDS_K0 + buf * KBUF + KSWZ(row, cb)) = s.k0; *(LAS bf16x8*)(lds + LDS_K0 + buf * KBUF + KSWZ(row + 32, cb)) = s.k1;
  *(LAS bf16x8*)(lds + LDS_V0 + buf * VBUF + row * VROW + cb) = s.v0; *(LAS bf16x8*)(lds + LDS_V0 + buf * VBUF + (row + 32) * VROW + cb) = s.v1;
}
DI void load_q(LAS char* qs, const bf16_t* qrow  ) {
#pragma unroll
  for (int d0 = 0; d0 < 8; ++d0) *(LAS bf16x8*)(qs + 1024 * d0) = *(const bf16x8*)(qrow + 16 * d0);
}
DI void qkt(f32x16& p0, f32x16& p1, LAS char* Kb, LAS char* qs, int r32, int hi) {
  for (int i = 0; i < 16; ++i) { p0[i] = 0.f; p1[i] = 0.f; }
#pragma unroll
  for (int d0 = 0; d0 < 8; ++d0) { const int cb = (d0 * 16 + hi * 8) * 2;
    const bf16x8 a0 = *(LAS bf16x8*)(Kb + KSWZ(r32, cb)); const bf16x8 a1 = *(LAS bf16x8*)(Kb + KSWZ(32 + r32, cb));
    const bf16x8 qf = *(LAS bf16x8*)(qs + 1024 * d0);
    p0 = MFMA32(a0, qf, p0); p1 = MFMA32(a1, qf, p1); }
}
DI bf16x8 pack8(const f32x16& p, int base) {
  u32x4 w; w.x = cvt2(p[base], p[base + 1]); w.y = cvt2(p[base + 2], p[base + 3]); w.z = cvt2(p[base + 4], p[base + 5]); w.w = cvt2(p[base + 6], p[base + 7]);
  return __builtin_bit_cast(bf16x8, w);
}
DI void pv(f32x16 (&o)[4], LAS char* Vb, const f32x16& p0, const f32x16& p1, int lane) {
  bf16x8 pf[4]; pf[0] = pack8(p0, 0); pf[1] = pack8(p0, 8); pf[2] = pack8(p1, 0); pf[3] = pack8(p1, 8);
  const int hi = lane >> 5, i16 = lane & 15, q = i16 >> 2, pp = i16 & 3, blk = (lane >> 4) & 1;
  LAS char* vb = Vb + (4 * hi + q) * VROW + (16 * blk + 4 * pp) * 2;
#pragma unroll
  for (int db = 0; db < 4; ++db) {
    __builtin_amdgcn_sched_barrier(0);
#pragma unroll
    for (int s = 0; s < 4; ++s) {
      const s16x4 lo = __builtin_amdgcn_ds_read_tr16_b64_v4i16((LAS s16x4*)(vb + (16 * s) * VROW + 64 * db));
      const s16x4 hh = __builtin_amdgcn_ds_read_tr16_b64_v4i16((LAS s16x4*)(vb + (16 * s + 8) * VROW + 64 * db));
      const bf16x8 vf = __builtin_shufflevector(lo, hh, 0, 1, 2, 3, 4, 5, 6, 7);
      o[db] = MFMA32(vf, pf[s], o[db]);
    }
  }
  __builtin_amdgcn_sched_barrier(0);
}
DI float pair_max(float v) { const auto rr = __builtin_amdgcn_permlane32_swap(__float_as_uint(v), __float_as_uint(v), false, false); return fmaxf(__uint_as_float(rr[0]), __uint_as_float(rr[1])); }
DI float pair_sum(float v) { const auto rr = __builtin_amdgcn_permlane32_swap(__float_as_uint(v), __float_as_uint(v), false, false); return __uint_as_float(rr[0]) + __uint_as_float(rr[1]); }
DI void softmax_tile(f32x16& p0, f32x16& p1, int lo, int hh, bool lane_on, bool elem_mask, float& m_run, float& l_run, f32x16 (&o)[4], int hi) {
  const float NINF = -__builtin_inff();
  if (elem_mask) {
#pragma unroll
    for (int r = 0; r < 16; ++r) { const int kk = crow(r, hi); const bool v0 = kk >= lo && kk <= hh, v1 = (kk + 32) >= lo && (kk + 32) <= hh;
      p0[r] = v0 ? p0[r] : NINF; p1[r] = v1 ? p1[r] : NINF; }
  }
  float pm = fmaxf(p0[0], p1[0]);
#pragma unroll
  for (int r = 1; r < 16; ++r) pm = fmaxf(fmaxf(pm, p0[r]), p1[r]);
  pm = lane_on ? pm : NINF;
  pm = pair_max(pm) * QK_C;
  if (!__all(pm <= m_run + 8.0f)) {
    const float mn = fmaxf(m_run, pm), alpha = __builtin_amdgcn_exp2f(m_run - mn); m_run = mn; l_run *= alpha;
#pragma unroll
    for (int db = 0; db < 4; ++db)
#pragma unroll
      for (int r = 0; r < 16; ++r) o[db][r] *= alpha;
  }
  const float nm = lane_on ? -m_run : NINF;
  float ls = 0.f;
#pragma unroll
  for (int r = 0; r < 16; ++r) { p0[r] = __builtin_amdgcn_exp2f(fmaf(p0[r], QK_C, nm)); ls += p0[r]; }
#pragma unroll
  for (int r = 0; r < 16; ++r) { p1[r] = __builtin_amdgcn_exp2f(fmaf(p1[r], QK_C, nm)); ls += p1[r]; }
  l_run += ls;
}
#define WBAR() do { asm volatile("s_waitcnt lgkmcnt(0)" ::: "memory"); __builtin_amdgcn_s_barrier(); asm volatile("" ::: "memory"); } while (0)
#define FP_COMPUTE(J, BUF) do { \
    const int tile_ = tile0 + (J), key0_ = tile_ * 64; \
    const bool lsel_ = (sel >> tile_) & 1ull; const int lo_ = klo - key0_, hh_ = khi - key0_; \
    const bool on_ = lsel_ && hh_ >= 0 && lo_ <= 63, fullv_ = lo_ <= 0 && hh_ >= 63; \
    f32x16 p0, p1; \
    qkt(p0, p1, lds + LDS_K0 + (BUF) * KBUF, qs, r32, hi); \
    softmax_tile(p0, p1, lo_, hh_, on_, __any(on_ && !fullv_), m_run, l_run, o, hi); \
    pv(o, lds + LDS_V0 + (BUF) * VBUF, p0, p1, lane); \
  } while (0)
DI void flash_pass(int tid, const bf16_t* Kg, int ldk, const bf16_t* Vg, int ldv, int tile0, int ntiles, LAS char* qs,
                   int klo, int khi, unsigned long long sel, f32x16 (&o)[4], float& m_run, float& l_run, LAS char* lds) {
  const int lane = tid & 63, r32 = lane & 31, hi = lane >> 5;
  const int first = tile0 * 64, last = (tile0 + ntiles - 1) * 64;
  Stage sA, sB;
  stage_load(tid, sA, Kg, ldk, Vg, ldv, first); stage_write(tid, sA, lds, 0);
  { const int k = first + 64; stage_load(tid, sA, Kg, ldk, Vg, ldv, k < last ? k : last); }
  { const int k = first + 128; stage_load(tid, sB, Kg, ldk, Vg, ldv, k < last ? k : last); }
  WBAR();
  for (int it = 0; it < ntiles; it += 2) {
    FP_COMPUTE(it, 0);
    stage_write(tid, sA, lds, 1);
    { const int k = first + (it + 3) * 64; stage_load(tid, sA, Kg, ldk, Vg, ldv, k < last ? k : last); }
    WBAR();
    if (it + 1 < ntiles) FP_COMPUTE(it + 1, 1);
    stage_write(tid, sB, lds, 0);
    { const int k = first + (it + 4) * 64; stage_load(tid, sB, Kg, ldk, Vg, ldv, k < last ? k : last); }
    WBAR();
  }
  __syncthreads();
}
constexpr int K2BUF = 8192, V2ROW = 576, V2BUF = 32 * V2ROW, LDS2_K0 = 0, LDS2_V0 = 2 * K2BUF;
struct Stage2 { bf16x8 k0, v0, v1; };
DI void stage2_load(int tid, Stage2& s, const bf16_t* __restrict__ Kg, int ldk, const bf16_t* __restrict__ Vg, int ldv, int key0) {
  s.k0 = *(const bf16x8*)(Kg + (size_t)(key0 + (tid >> 4)) * ldk + (tid & 15) * 8);
  const bf16_t* vp = Vg + (size_t)((tid >> 4) & 1) * SEQ * 128 + (tid & 15) * 8;
  s.v0 = *(const bf16x8*)(vp + (size_t)(key0 + (tid >> 5)) * ldv);
  s.v1 = *(const bf16x8*)(vp + (size_t)(key0 + 16 + (tid >> 5)) * ldv);
}
DI void stage2_write(int tid, const Stage2& s, LAS char* lds, int buf) {
  *(LAS bf16x8*)(lds + LDS2_K0 + buf * K2BUF + KSWZ(tid >> 4, (tid & 15) * 16)) = s.k0;
  *(LAS bf16x8*)(lds + LDS2_V0 + buf * V2BUF + (tid >> 5) * V2ROW + (tid & 31) * 16) = s.v0;
  *(LAS bf16x8*)(lds + LDS2_V0 + buf * V2BUF + (16 + (tid >> 5)) * V2ROW + (tid & 31) * 16) = s.v1;
}
#define F256_COMPUTE(IT, BUF) do { \
    const int hh = t - (IT) * 32; \
    f32x16 p0; for (int i = 0; i < 16; ++i) p0[i] = 0.f; \
    LAS char* Kb = lds + LDS2_K0 + (BUF) * K2BUF; \
    _Pragma("unroll") for (int d0 = 0; d0 < 8; ++d0) { const int cb = (d0 * 16 + hi * 8) * 2; const bf16x8 a0 = *(LAS bf16x8*)(Kb + KSWZ(r32, cb)); const bf16x8 qf = *(LAS bf16x8*)(qs + 1024 * d0); p0 = MFMA32(a0, qf, p0); } \
    if (!__all(hh >= 31)) { _Pragma("unroll") for (int r = 0; r < 16; ++r) p0[r] = crow(r, hi) <= hh ? p0[r] : NINF; } \
    float pm = p0[0]; \
    _Pragma("unroll") for (int r = 1; r < 16; ++r) pm = fmaxf(pm, p0[r]); \
    pm = pair_max(pm) * QK_C; \
    if (!__all(pm <= m_run + 8.0f)) { \
      const float mn = fmaxf(m_run, pm), alpha = __builtin_amdgcn_exp2f(m_run - mn); m_run = mn; l_run *= alpha; \
      _Pragma("unroll") for (int db = 0; db < 8; ++db) _Pragma("unroll") for (int r = 0; r < 16; ++r) o[db][r] *= alpha; } \
    const float nm = -m_run; float ls = 0.f; \
    _Pragma("unroll") for (int r = 0; r < 16; ++r) { p0[r] = __builtin_amdgcn_exp2f(fmaf(p0[r], QK_C, nm)); ls += p0[r]; } \
    l_run += ls; \
    bf16x8 pf[2]; pf[0] = pack8(p0, 0); pf[1] = pack8(p0, 8); \
    LAS char* vb = lds + LDS2_V0 + (BUF) * V2BUF + (4 * hi + q) * V2ROW + (16 * blk + 4 * pp) * 2; \
    _Pragma("unroll") for (int db = 0; db < 8; ++db) { \
      __builtin_amdgcn_sched_barrier(0); \
      _Pragma("unroll") for (int s2 = 0; s2 < 2; ++s2) { \
        const s16x4 lo = __builtin_amdgcn_ds_read_tr16_b64_v4i16((LAS s16x4*)(vb + (16 * s2) * V2ROW + 64 * db)); \
        const s16x4 h2 = __builtin_amdgcn_ds_read_tr16_b64_v4i16((LAS s16x4*)(vb + (16 * s2 + 8) * V2ROW + 64 * db)); \
        const bf16x8 vf = __builtin_shufflevector(lo, h2, 0, 1, 2, 3, 4, 5, 6, 7); \
        o[db] = MFMA32(vf, pf[s2], o[db]); } } \
    __builtin_amdgcn_sched_barrier(0); \
  } while (0)
DI void flash256_pass(int tid, const bf16_t* Kg, int ldk, const bf16_t* Vg, int ldv, int ntiles, LAS char* qs, int t, f32x16 (&o)[8], float& m_run, float& l_run, LAS char* lds) {
  const int lane = tid & 63, r32 = lane & 31, hi = lane >> 5;
  const int i16 = lane & 15, q = i16 >> 2, pp = i16 & 3, blk = (lane >> 4) & 1;
  const float NINF = -__builtin_inff();
  Stage2 sA, sB;
  const int last = (ntiles - 1) * 32;
  stage2_load(tid, sA, Kg, ldk, Vg, ldv, 0); stage2_write(tid, sA, lds, 0);
  stage2_load(tid, sA, Kg, ldk, Vg, ldv, 32);
  stage2_load(tid, sB, Kg, ldk, Vg, ldv, 64);
  WBAR();
  for (int it = 0; it < ntiles; it += 2) {
    F256_COMPUTE(it, 0);
    stage2_write(tid, sA, lds, 1);
    { const int k = (it + 3) * 32; stage2_load(tid, sA, Kg, ldk, Vg, ldv, k < last ? k : last); }
    WBAR();
    F256_COMPUTE(it + 1, 1);
    stage2_write(tid, sB, lds, 0);
    { const int k = (it + 4) * 32; stage2_load(tid, sB, Kg, ldk, Vg, ldv, k < last ? k : last); }
    WBAR();
  }
  __syncthreads();
}
#define LADD(ptr, v) __hip_atomic_fetch_add((ptr), (v), __ATOMIC_RELAXED, __HIP_MEMORY_SCOPE_WORKGROUP)
DI void cmp_importance(int tid, const bf16_t* Kg, int ntiles, LAS char* qs, int khi, float m_fin, float inv_l, int tl, LAS char* lds) {
  const int lane = tid & 63, r32 = lane & 31, hi = lane >> 5;
  LAS int* imp = (LAS int*)(lds + LDS_IMP) + tl * 65;
  const float NINF = -__builtin_inff();
  Stage st;
  stage_load(tid, st, Kg, 128, Kg, 128, 0); stage_write(tid, st, lds, 0); __syncthreads();
  for (int it = 0; it < ntiles; ++it) {
    const int key0 = it * 64, buf = it & 1;
    if (it + 1 < ntiles) stage_load(tid, st, Kg, 128, Kg, 128, key0 + 64);
    const int hh = khi - key0;
    if (__any(hh >= 0)) {
      f32x16 p0, p1; qkt(p0, p1, lds + LDS_K0 + buf * KBUF, qs, r32, hi);
#pragma unroll
      for (int r = 0; r < 16; ++r) { const int kk = crow(r, hi);
        p0[r] = kk <= hh ? __builtin_amdgcn_exp2f(fmaf(p0[r], QK_C, -m_fin)) * inv_l : 0.f;
        p1[r] = (kk + 32) <= hh ? __builtin_amdgcn_exp2f(fmaf(p1[r], QK_C, -m_fin)) * inv_l : 0.f; }
#pragma unroll
      for (int q = 0; q < 4; ++q) {
        const float a0 = (p0[4 * q] + p0[4 * q + 1]) + (p0[4 * q + 2] + p0[4 * q + 3]), a1 = (p1[4 * q] + p1[4 * q + 1]) + (p1[4 * q + 2] + p1[4 * q + 3]);
        const int g0 = 16 * it + 2 * q + hi, g1 = g0 + 8;
        LADD(imp + g0, (int)(a0 * 67108864.0f + 0.5f)); LADD(imp + g1, (int)(a1 * 67108864.0f + 0.5f));
        LADD(imp + g0 + 1, (int)(p0[4 * q + 3] * 67108864.0f + 0.5f));
        if (g1 + 1 < 64) LADD(imp + g1 + 1, (int)(p1[4 * q + 3] * 67108864.0f + 0.5f));
      }
    }
    if (it + 1 < ntiles) stage_write(tid, st, lds, buf ^ 1);
    __syncthreads();
  }
  (void)NINF;
}
DI void sb_pass(int tid, const bf16_t* Kg, int ldk, const bf16_t* Vg, int ldv, int tile_hi, LAS char* qs, int t, f32x16 (&o)[4], LAS char* lds) {
  const int lane = tid & 63, w = __builtin_amdgcn_readfirstlane(tid >> 6), r32 = lane & 31, hi = lane >> 5;
  LAS int* flags = (LAS int*)(lds + LDS_MISC);
  const float NINF = -__builtin_inff();
  float carry = 0.f;
  Stage st;
  stage_load(tid, st, Kg, ldk, Vg, ldv, tile_hi * 64); stage_write(tid, st, lds, 0); __syncthreads();
  for (int it = 0;; ++it) {
    const int tile = tile_hi - it, key0 = tile * 64, buf = it & 1;
    const bool more = tile > 0;
    if (more) stage_load(tid, st, Kg, ldk, Vg, ldv, key0 - 64);
    const int hh = t - 1 - key0;
    if (__any(hh >= 0)) {
      f32x16 p0, p1; qkt(p0, p1, lds + LDS_K0 + buf * KBUF, qs, r32, hi);
      float l0[16], l1[16];
#pragma unroll
      for (int r = 0; r < 16; ++r) { const int kk = crow(r, hi);
        { const float Z = p0[r] * QK_C; const float sp = fmaxf(Z, 0.f) + __builtin_amdgcn_logf(1.0f + __builtin_amdgcn_exp2f(-fabsf(Z))); const bool v = kk <= hh; l0[r] = v ? -sp : 0.f; p0[r] = v ? Z - sp : NINF; }
        { const float Z = p1[r] * QK_C; const float sp = fmaxf(Z, 0.f) + __builtin_amdgcn_logf(1.0f + __builtin_amdgcn_exp2f(-fabsf(Z))); const bool v = (kk + 32) <= hh; l1[r] = v ? -sp : 0.f; p1[r] = v ? Z - sp : NINF; } }
      float run = 0.f;
#pragma unroll
      for (int q = 3; q >= 0; --q) { const float A = (l1[4 * q] + l1[4 * q + 1]) + (l1[4 * q + 2] + l1[4 * q + 3]); const float Ap = __shfl_xor(A, 32, 64);
        const float T = carry + run + (hi == 0 ? Ap : 0.f);
        const float e2 = l1[4 * q + 3], e1 = e2 + l1[4 * q + 2], e0 = e1 + l1[4 * q + 1];
        p1[4 * q + 3] = __builtin_amdgcn_exp2f(p1[4 * q + 3] + T); p1[4 * q + 2] = __builtin_amdgcn_exp2f(p1[4 * q + 2] + T + e2);
        p1[4 * q + 1] = __builtin_amdgcn_exp2f(p1[4 * q + 1] + T + e1); p1[4 * q] = __builtin_amdgcn_exp2f(p1[4 * q] + T + e0);
        run += A + Ap; }
#pragma unroll
      for (int q = 3; q >= 0; --q) { const float A = (l0[4 * q] + l0[4 * q + 1]) + (l0[4 * q + 2] + l0[4 * q + 3]); const float Ap = __shfl_xor(A, 32, 64);
        const float T = carry + run + (hi == 0 ? Ap : 0.f);
        const float e2 = l0[4 * q + 3], e1 = e2 + l0[4 * q + 2], e0 = e1 + l0[4 * q + 1];
        p0[4 * q + 3] = __builtin_amdgcn_exp2f(p0[4 * q + 3] + T); p0[4 * q + 2] = __builtin_amdgcn_exp2f(p0[4 * q + 2] + T + e2);
        p0[4 * q + 1] = __builtin_amdgcn_exp2f(p0[4 * q + 1] + T + e1); p0[4 * q] = __builtin_amdgcn_exp2f(p0[4 * q] + T + e0);
        run += A + Ap; }
      carry += run;
      pv(o, lds + LDS_V0 + buf * VBUF, p0, p1, lane);
    }
    const int wdone = __all(carry < -150.0f) ? 1 : 0;
    if (lane == 0) flags[(it & 1) * 8 + w] = wdone;
    if (more) stage_write(tid, st, lds, buf ^ 1);
    __syncthreads();
    int alld = 1;
#pragma unroll
    for (int i = 0; i < 8; ++i) alld &= flags[(it & 1) * 8 + i];
    if (!more || alld) break;
  }
  __syncthreads();
}

DI int next_item(int* counter, LAS char* lds) {
  LAS int* slot = (LAS int*)(lds + LDS_MISC + 128);
  if (threadIdx.x == 0) *slot = atomicAdd(counter, 1);
  __syncthreads(); const int v = __builtin_amdgcn_readfirstlane(*slot); __syncthreads(); return v;
}
DI void zero_o(f32x16 (&o)[4]) {
#pragma unroll
  for (int db = 0; db < 4; ++db)
#pragma unroll
    for (int r = 0; r < 16; ++r) o[db][r] = 0.f;
}
#define ST_NEXT(ptr) do { (ptr) += 2048; asm volatile("" : "+v"(ptr)); } while (0)
DI void stash_set(float* st, const f32x16 (&o)[4], float sc) {
#pragma unroll
  for (int db = 0; db < 4; ++db)
#pragma unroll
    for (int q4 = 0; q4 < 4; ++q4) { f32x4 v = {o[db][4 * q4] * sc, o[db][4 * q4 + 1] * sc, o[db][4 * q4 + 2] * sc, o[db][4 * q4 + 3] * sc}; *(f32x4*)st = v; ST_NEXT(st); }
}
DI void stash_add(float* st, const f32x16 (&o)[4], float sc) {
#pragma unroll
  for (int db = 0; db < 4; ++db)
#pragma unroll
    for (int q4 = 0; q4 < 4; ++q4) { f32x4 v = *(const f32x4*)st; v[0] += o[db][4 * q4] * sc; v[1] += o[db][4 * q4 + 1] * sc; v[2] += o[db][4 * q4 + 2] * sc; v[3] += o[db][4 * q4 + 3] * sc; *(f32x4*)st = v; ST_NEXT(st); }
}
DI void nsa_item(const Params& p, int item, LAS char* lds, float* stash) {
  const int tid = otid(), w = __builtin_amdgcn_readfirstlane(tid >> 6), lane = tid & 63, r32 = lane & 31, hi = lane >> 5;
  const int jc = 63 - (item >> 2), b = (item >> 1) & 1, hk = item & 1, g = w & 3, qh = w >> 2;
  const int t0 = jc * 64, tl = 32 * qh + r32, t = t0 + tl, head = hk * 4 + g; const size_t row = (size_t)b * SEQ + t;
  const bf16_t* H0 = (const bf16_t*)(p.ws + OFF_E);
  const bf16_t* Qraw = (const bf16_t*)(p.ws + OFF_QRAW);
  const bf16_t* Kc = (const bf16_t*)(p.ws + OFF_KCMP) + (size_t)(b * 2 + hk) * 256 * 128; const bf16_t* Vc = (const bf16_t*)(p.ws + OFF_VCMP) + (size_t)(b * 2 + hk) * 256 * 128;
  bf16_t* Ocat = (bf16_t*)(p.ws + OFF_A);
  float* st = stash + (size_t)blockIdx.x * 32768 + tid * 4;
  const bf16_t* gap = HBLK(H0, NB0, b, 60) + (size_t)t * 128 + head * 3;
  const float g0 = sigmoid_f(bf_lo((unsigned)gap[0])), g1 = sigmoid_f(bf_lo((unsigned)gap[1])), g2 = sigmoid_f(bf_lo((unsigned)gap[2]));
  LAS int* imp = (LAS int*)(lds + LDS_IMP); LAS unsigned* msk = (LAS unsigned*)(lds + LDS_MASK);
  for (int i = tid; i < 64 * 65; i += 512) imp[i] = 0;
  if (tid < 128) msk[tid] = 0u;
  LAS char* qs = lds + LDS_Q + w * 8192 + lane * 16; f32x16 o[4]; float m_run, l_run;
  load_q(qs, Qraw + row * 1024 + head * 128 + 8 * hi);
  const int nmax = t >= 31 ? (t - 31) >> 4 : -1;
  const int ncm = (((t0 + 63 - 31) >> 4) >> 6) + 1;
  zero_o(o); m_run = -1e30f; l_run = 0.f;
  flash_pass(tid, Kc, 128, Vc, 128, 0, ncm, qs, 0, nmax, ~0ull, o, m_run, l_run, lds);
  { const float lt = pair_sum(l_run), inv = lt > 0.f ? 1.0f / lt : 0.f; stash_set(st, o, inv * g0);
    if (jc >= 16) cmp_importance(tid, Kc, ncm, qs, nmax, m_run, inv, tl, lds); }
  unsigned long long sel = ~0ull;
  if (jc >= 16) {
    __syncthreads();
#pragma unroll 1
    for (int qi = 0; qi < 8; ++qi) { const int q = 8 * w + qi, j = lane;
      const bool forced = j == 0 || j == jc || j == jc - 1; const int sc = forced ? 0x7fffffff : (j <= jc ? imp[q * 65 + j] : -1);
      int rank = 0;
#pragma unroll
      for (int j2 = 0; j2 < 64; ++j2) { const int s2 = __builtin_amdgcn_readlane(sc, j2); rank += (s2 > sc || (s2 == sc && j2 < j)) ? 1 : 0; }
      const unsigned long long m = __ballot(rank < 16 && j <= jc);
      if (lane == 0) { msk[2 * q] = (unsigned)m; msk[2 * q + 1] = (unsigned)(m >> 32); } }
    __syncthreads();
    sel = (unsigned long long)msk[2 * tl] | ((unsigned long long)msk[2 * tl + 1] << 32);
  }
  load_q(qs, HBLK(H0, NB0, b, head) + (size_t)t * 128 + 8 * hi);
  zero_o(o); m_run = -1e30f; l_run = 0.f;
  flash_pass(tid, HBLK(H0, NB0, b, 12 + hk), 128, HBLK(H0, NB0, b, 14 + hk), 128, 0, jc + 1, qs, 0, t, sel, o, m_run, l_run, lds);
  { const float lt = pair_sum(l_run), inv = lt > 0.f ? 1.0f / lt : 0.f; stash_add(st, o, inv * g1); }
  const int wt0 = jc >= 8 ? jc - 8 : 0;
  zero_o(o); m_run = -1e30f; l_run = 0.f;
  flash_pass(tid, HBLK(H0, NB0, b, 16 + hk), 128, HBLK(H0, NB0, b, 18 + hk), 128, wt0, jc - wt0 + 1, qs, t - 511, t, ~0ull, o, m_run, l_run, lds);
  { const float lt = pair_sum(l_run), inv = (lt > 0.f ? 1.0f / lt : 0.f) * g2;
    const bf16_t* gate = HBLK(H0, NB0, b, 20 + head) + (size_t)t * 128; bf16_t* dst = Ocat + row * DM + head * 128; const float* stp = st;
#pragma unroll
    for (int db = 0; db < 4; ++db)
#pragma unroll
      for (int q4 = 0; q4 < 4; ++q4) { const int d = 32 * db + 8 * q4 + 4 * hi; const u32x2 gv = *(const u32x2*)(gate + d); float v[4];
        const f32x4 sv = *(const f32x4*)stp; ST_NEXT(stp);
#pragma unroll
        for (int i = 0; i < 4; ++i) v[i] = sv[i] + o[db][4 * q4 + i] * inv;
        u32x2 ov; ov.x = cvt2(v[0] * silu_f(bf_lo(gv.x)), v[1] * silu_f(bf_hi(gv.x))); ov.y = cvt2(v[2] * silu_f(bf_lo(gv.y)), v[3] * silu_f(bf_hi(gv.y)));
        *(u32x2*)(dst + d) = ov; } }
}
DI void sb_item(const Params& p, int idx, LAS char* lds) {
  const int tid = otid(), w = __builtin_amdgcn_readfirstlane(tid >> 6), lane = tid & 63, r32 = lane & 31, hi = lane >> 5;
  const int qb = 15 - (idx >> 4), b = (idx >> 3) & 1, h = idx & 7, t = 256 * qb + 32 * w + r32; const size_t row = (size_t)b * SEQ + t;
  const bf16_t* H0 = (const bf16_t*)(p.ws + OFF_E); bf16_t* Ocat = (bf16_t*)(p.ws + OFF_A);
  LAS char* qs = lds + LDS_Q + w * 8192 + lane * 16; f32x16 o[4]; load_q(qs, HBLK(H0, NB0, b, 28 + h) + (size_t)t * 128 + 8 * hi); zero_o(o);
  sb_pass(tid, HBLK(H0, NB0, b, 36 + h), 128, HBLK(H0, NB0, b, 44 + h), 128, 4 * qb + 3, qs, t, o, lds);
  const bf16_t* gate = HBLK(H0, NB0, b, 52 + h) + (size_t)t * 128; bf16_t* dst = Ocat + row * DM + 1024 + h * 128;
#pragma unroll
  for (int db = 0; db < 4; ++db)
#pragma unroll
    for (int q4 = 0; q4 < 4; ++q4) { const int d = 32 * db + 8 * q4 + 4 * hi; const u32x2 gv = *(const u32x2*)(gate + d);
      u32x2 ov; ov.x = cvt2(o[db][4 * q4] * silu_f(bf_lo(gv.x)), o[db][4 * q4 + 1] * silu_f(bf_hi(gv.x))); ov.y = cvt2(o[db][4 * q4 + 2] * silu_f(bf_lo(gv.y)), o[db][4 * q4 + 3] * silu_f(bf_hi(gv.y)));
      *(u32x2*)(dst + d) = ov; }
}
DI void diff_item(const Params& p, int item, LAS char* lds) {
  const int tid = otid(), w = __builtin_amdgcn_readfirstlane(tid >> 6), lane = tid & 63, r32 = lane & 31, hi = lane >> 5;
  const int qb = 15 - (item >> 5), b = (item >> 4) & 1, h = (item >> 1) & 7, c = item & 1, t = 256 * qb + 32 * w + r32; const size_t row = (size_t)b * SEQ + t;
  const bf16_t* H1 = (const bf16_t*)(p.ws + OFF_E);
  bf16_t* Oc = (bf16_t*)(p.ws + (c ? OFF_B : OFF_A));
  LAS char* qs = lds + LDS_Q + w * 8192 + lane * 16; f32x16 o[8]; float m_run = -1e30f, l_run = 0.f;
#pragma unroll
  for (int db = 0; db < 8; ++db)
#pragma unroll
    for (int r = 0; r < 16; ++r) o[db][r] = 0.f;
  load_q(qs, HBLK(H1, NB1, b, 2 * h + c) + (size_t)t * 128 + 8 * hi);
  flash256_pass(tid, HBLK(H1, NB1, b, 16 + 2 * h + c), 128, HBLK(H1, NB1, b, 32 + 2 * h), 128, 8 * qb + 8, qs, t, o, m_run, l_run, lds);
  const float lt = pair_sum(l_run), inv = lt > 0.f ? 1.0f / lt : 0.f;
  bf16_t* dst = Oc + row * DM + h * 256;
#pragma unroll
  for (int db = 0; db < 8; ++db)
#pragma unroll
    for (int q4 = 0; q4 < 4; ++q4) { const int d = 32 * db + 8 * q4 + 4 * hi;
      u32x2 ov; ov.x = cvt2(o[db][4 * q4] * inv, o[db][4 * q4 + 1] * inv); ov.y = cvt2(o[db][4 * q4 + 2] * inv, o[db][4 * q4 + 3] * inv); *(u32x2*)(dst + d) = ov; }
}

#define XB_TMO      128
#define XB_XCNT(j)  (256  + 64 * (j))
#define XB_XSUB(j)  (1280 + 64 * (j))
#define XB_XGEN(j)  (2304 + 64 * (j))
#define XB_TOP      3328
#define XB_TOPGEN   3392
#define XCD_BAR_WORDS 3456
#define XB_SPIN_CAP (1u << 18)
DI unsigned xb_ld(unsigned* p)              { return __hip_atomic_load(p, __ATOMIC_RELAXED, __HIP_MEMORY_SCOPE_AGENT); }
DI unsigned xb_add(unsigned* p, unsigned v) { return __hip_atomic_fetch_add(p, v, __ATOMIC_RELAXED, __HIP_MEMORY_SCOPE_AGENT); }
DI unsigned xb_xcc_id() { return (unsigned)__builtin_amdgcn_s_getreg((3 << 11) | 20) & 0xFu; }
#define XB_SPIN(cond, bar) do { unsigned _sp = 0; while (cond) { __builtin_amdgcn_s_sleep(1); \
    if ((++_sp & 255u) == 0u) { if (xb_ld(&(bar)[XB_TMO])) break; if (_sp > XB_SPIN_CAP) { atomicAdd(&(bar)[XB_TMO], 1u); break; } } } } while (0)
struct XcdBarrier { unsigned* bar; unsigned x; volatile LAS unsigned* st; };
DI XcdBarrier xcd_barrier_post(unsigned* bar, volatile LAS unsigned* st) {
    XcdBarrier b; b.bar = bar; b.x = xb_xcc_id(); b.st = st;
    if (threadIdx.x == 0) (void)xb_add(&bar[XB_XCNT(b.x)], 1u);
    return b;
}
DI void xcd_barrier_complete(unsigned* bar, unsigned x, unsigned& nloc, unsigned& nx) {
    const unsigned G = gridDim.x * gridDim.y * gridDim.z;
    unsigned sum, cntx, mine, sp = 0u;
    for (;;) {
        sum = 0u; cntx = 0u; mine = 0u;
#pragma unroll
        for (unsigned j = 0; j < 16; ++j) { const unsigned c = xb_ld(&bar[XB_XCNT(j)]); sum += c; cntx += (c > 0u) ? 1u : 0u; mine = (j == x) ? c : mine; }
        if (sum == G) break;
        __builtin_amdgcn_s_sleep(1);
        if ((++sp & 255u) == 0u) { if (xb_ld(&bar[XB_TMO])) break; if (sp > XB_SPIN_CAP) { atomicAdd(&bar[XB_TMO], 1u); break; } }
    }
    nloc = mine > 0u ? mine : 1u; nx = cntx > 0u ? cntx : 1u;
}
DI void xcd_barrier(const XcdBarrier& b) {
    asm volatile("s_waitcnt vmcnt(0)" ::: "memory");
    __syncthreads();
    if (threadIdx.x == 0) {
        unsigned* bar = b.bar;
        __builtin_amdgcn_s_waitcnt(0);
        unsigned nloc = b.st[0], nx = b.st[1];
        if (nloc == 0u) { xcd_barrier_complete(bar, b.x, nloc, nx); b.st[0] = nloc; b.st[1] = nx; }
        const unsigned old = xb_add(&bar[XB_XSUB(b.x)], 1u);
        const unsigned gen = old / nloc;
        if (old + 1u == (gen + 1u) * nloc) {
            __builtin_amdgcn_fence(__ATOMIC_RELEASE, "agent");
            asm volatile("s_waitcnt vmcnt(0)" ::: "memory");
            const unsigned og = xb_add(&bar[XB_TOP], 1u);
            const unsigned tg = og / nx;
            if (og + 1u == (tg + 1u) * nx) xb_add(&bar[XB_TOPGEN], 1u);
            else XB_SPIN(xb_ld(&bar[XB_TOPGEN]) == tg, bar);
            __builtin_amdgcn_fence(__ATOMIC_ACQUIRE, "agent");
            xb_add(&bar[XB_XGEN(b.x)], 1u);
            asm volatile("s_waitcnt vmcnt(0)" ::: "memory");
        } else {
            XB_SPIN(xb_ld(&bar[XB_XGEN(b.x)]) == gen, bar);
            __builtin_amdgcn_fence(__ATOMIC_ACQUIRE, "agent");
            asm volatile("s_waitcnt vmcnt(0)" ::: "memory");
        }
    }
    __syncthreads();
}

__global__ void __launch_bounds__(512) mega(Params p) {
  extern __shared__ __attribute__((aligned(16))) unsigned char shm[];
  LAS char* lds = (LAS char*)shm;
  cg::grid_group grid = cg::this_grid();
  const int bid = blockIdx.x, nb = gridDim.x;
  char* ws = p.ws;
  if (ws == nullptr) grid.sync();
  volatile LAS unsigned* xst = (volatile LAS unsigned*)(lds + LDS_XB);
  if (threadIdx.x == 0) { xst[0] = 0u; xst[1] = 0u; }
  __syncthreads();
  const XcdBarrier xbar = xcd_barrier_post((unsigned*)(ws + OFF_BAR), xst);
#define Xb ((bf16_t*)(ws + OFF_A))
#define cosT ((float*)(ws + OFF_COS))
#define sinT ((float*)(ws + OFF_SIN))
#define cnt ((int*)(ws + OFF_CNT))
#define lamp ((float*)(ws + OFF_CNT + 64))
#define PHASE_IDS int tid = threadIdx.x; asm volatile("" : "+v"(tid)); const size_t gtid = (size_t)bid * 512 + tid, gsz = (size_t)nb * 512; (void)gtid; (void)gsz;

  for (int rep0 = 0; rep0 < REP_P0; ++rep0) { PHASE_IDS
    for (size_t i = gtid; i < (size_t)NTOK * DM / 8; i += gsz) { const f32x4 a = ((const f32x4*)p.x)[2 * i], c = ((const f32x4*)p.x)[2 * i + 1];
      u32x4 w; w.x = cvt2(a[0], a[1]); w.y = cvt2(a[2], a[3]); w.z = cvt2(c[0], c[1]); w.w = cvt2(c[2], c[3]); ((u32x4*)Xb)[i] = w; }
    for (size_t i = gtid; i < (size_t)SEQ * 64; i += gsz) { const int t = (int)(i >> 6), f = (int)(i & 63);
      const float inv = (float)exp2(-(double)f * (13.287712379549449 / 64.0));
      const float ang = (float)t * inv; double rev = (double)ang * 0.15915494309189535; rev -= floor(rev); const float rf = (float)rev;
      cosT[i] = __builtin_amdgcn_cosf(rf); sinT[i] = __builtin_amdgcn_sinf(rf); }
    if (gtid == 0) { for (int i = 0; i < 8; ++i) cnt[i] = 0; float s1 = 0.f, s2 = 0.f; for (int i = 0; i < 128; ++i) { s1 += p.od_lq1[i] * p.od_lk1[i]; s2 += p.od_lq2[i] * p.od_lk2[i]; }
      lamp[0] = __expf(s1) - __expf(s2) + LAMBDA_INIT; }
    int base = 0; LAS float* tl = (LAS float*)lds;
    tr_matrix(p.ev_w_in, EV_IN, DM, N0, 1, (bf16_t*)(ws + OFF_B), base, bid, nb, tl);
    tr_matrix(p.ev_w_out, DM, DM, DM, 0, (bf16_t*)(ws + OFF_BTO0), base, bid, nb, tl);
    tr_matrix(p.ev_w1_k, 128, 4096, 128, 0, (bf16_t*)(ws + OFF_W1KT), base, bid, nb, tl);
    tr_matrix(p.ev_w1_v, 128, 4096, 128, 0, (bf16_t*)(ws + OFF_W1VT), base, bid, nb, tl);
    tr_matrix(p.ev_w2_k, 128, 128, 128, 3, (bf16_t*)(ws + OFF_W2KT), base, bid, nb, tl);
    tr_matrix(p.ev_w2_v, 128, 128, 128, 0, (bf16_t*)(ws + OFF_W2VT), base, bid, nb, tl);
  }
  xcd_barrier(xbar);
  { pg8::Gemm g{Xb, (const bf16_t*)(ws + OFF_B), NTOK, N0, DM}; pg8::StaticOrder S; S.init(NTOK, N0, nb, bid);
    pg8::EpiH E{(bf16_t*)(ws + OFF_E), NB0, (bf16_t*)(ws + OFF_QRAW), 1024, cosT, sinT, (1u << 6) | (1u << 8), 4, 4};
    for (int rep = 0; rep < REP_GEMM; ++rep) pg8::gemm_phase<pg8::EpiH, pg8::StaticOrder>((LAS unsigned char*)shm, g, S, E);
  }
  xcd_barrier(xbar);
  for (int rep2 = 0; rep2 < REP_P2; ++rep2)
  if (bid < 64) compress_block(p, bid, lds);
  xcd_barrier(xbar);
  for (int rep = 0; rep < REP_P3; ++rep) { if (rep) xcd_barrier(xbar);
  for (;;) { const int item = next_item(cnt + 2 * rep, lds); if (item >= 512 + 160) break;
    if (item >= 512) {
      LAS float* tl = (LAS float*)lds;
      for (int u = 0; u < 8; ++u) { const int ti = (item - 512) * 8 + u;
        if (ti < 1024) transpose_tile(p.od_w_in, N1, DM, 2, (bf16_t*)(ws + OFF_B), (ti >> 4) * 128, (ti & 15) * 128, tl);
        else transpose_tile(p.od_w_out, DM, DM, 0, (bf16_t*)(ws + OFF_BTO1), ((ti - 1024) >> 4) * 128, ((ti - 1024) & 15) * 128, tl); }
      continue; }
#ifndef SKIP_NSA
    if (item < 256) nsa_item(p, item, lds, p.out);
#endif
#ifndef SKIP_SB
    if (item >= 256) sb_item(p, item - 256, lds);
#endif
  } }
  xcd_barrier(xbar);
  { pg8::Gemm g{(const bf16_t*)(ws + OFF_A), (const bf16_t*)(ws + OFF_BTO0), NTOK, DM, DM}; pg8::StaticOrder S; S.init(NTOK, DM, nb, bid);
    pg8::EpiRes E{p.out, p.x, DM};
    for (int rep = 0; rep < REP_GEMM; ++rep) pg8::gemm_phase<pg8::EpiRes, pg8::StaticOrder>((LAS unsigned char*)shm, g, S, E);
  }
  xcd_barrier(xbar);
  for (int r = 0; r < REP_LN; ++r) ln_phase(p.out, p.ev_ln_g, p.ev_ln_b, nullptr, (bf16_t*)(ws + OFF_A), (float*)(ws + OFF_SSQ));
  for (int r = 0; r < REP_SYNC; ++r) xcd_barrier(xbar);
  xcd_barrier(xbar);
  { pg8::Gemm g{(const bf16_t*)(ws + OFF_A), (const bf16_t*)(ws + OFF_B), NTOK, N1, DM}; pg8::StaticOrder S; S.init(NTOK, N1, nb, bid);
    pg8::EpiH E{(bf16_t*)(ws + OFF_E), NB1, nullptr, 0, cosT, sinT, 0u, 16, 0};
    for (int rep = 0; rep < REP_GEMM; ++rep) pg8::gemm_phase<pg8::EpiH, pg8::StaticOrder>((LAS unsigned char*)shm, g, S, E);
  }
  xcd_barrier(xbar);
  {
    for (int rep = 0; rep < REP_P7; ++rep) { if (rep) xcd_barrier(xbar);
    for (;;) { const int item = next_item(cnt + 1 + 2 * rep, lds); if (item >= 512) break;
#ifndef SKIP_DIFF
      diff_item(p, item, lds);
#endif
    } } }
  xcd_barrier(xbar);
  { const int tid = otid(), w = tid >> 6, lane = tid & 63;
    const float lam = lamp[0];
    bf16_t* O0 = (bf16_t*)(ws + OFF_A); const bf16_t* O1 = (const bf16_t*)(ws + OFF_B); const bf16_t* H1 = (const bf16_t*)(ws + OFF_E);
    for (int pr = bid * 8 + w; pr < NTOK * 8; pr += nb * 8) { const size_t row = (size_t)(pr >> 3); const int h = pr & 7, c0 = h * 256 + 4 * lane;
      const u32x2 a = *(const u32x2*)(O0 + row * DM + c0), bq = *(const u32x2*)(O1 + row * DM + c0), gv = *(const u32x2*)(HBLK(H1, NB1, (int)(row >> 12), 48 + 2 * h + (lane >> 5)) + (size_t)(row & 4095) * 128 + ((4 * lane) & 127));
      const f32x4 gn = *(const f32x4*)(p.od_gn_g + c0);
      float u[4] = {bf_lo(a.x) - lam * bf_lo(bq.x), bf_hi(a.x) - lam * bf_hi(bq.x), bf_lo(a.y) - lam * bf_lo(bq.y), bf_hi(a.y) - lam * bf_hi(bq.y)};
      const float ss = wave_sum((u[0] * u[0] + u[1] * u[1]) + (u[2] * u[2] + u[3] * u[3]));
      const float r = __builtin_amdgcn_rsqf(ss * (1.0f / 256.0f) + 1e-5f) * (1.0f - LAMBDA_INIT);
      u32x2 ov; ov.x = cvt2(u[0] * r * gn[0] * silu_f(bf_lo(gv.x)), u[1] * r * gn[1] * silu_f(bf_hi(gv.x))); ov.y = cvt2(u[2] * r * gn[2] * silu_f(bf_lo(gv.y)), u[3] * r * gn[3] * silu_f(bf_hi(gv.y)));
      *(u32x2*)(O0 + row * DM + c0) = ov; } }
  xcd_barrier(xbar);
  { pg8::Gemm g{(const bf16_t*)(ws + OFF_A), (const bf16_t*)(ws + OFF_BTO1), NTOK, DM, DM}; pg8::StaticOrder S; S.init(NTOK, DM, nb, bid);
    pg8::EpiRes1 E{(float*)(ws + OFF_E), p.out, (const float*)(ws + OFF_SSQ), p.ev_ln_g, p.ev_ln_b, DM};
    for (int rep = 0; rep < REP_GEMM; ++rep) pg8::gemm_phase<pg8::EpiRes1, pg8::StaticOrder>((LAS unsigned char*)shm, g, S, E);
  }
  xcd_barrier(xbar);
  for (int r = 0; r < REP_LN; ++r) ln_phase((const float*)(ws + OFF_E), p.od_ln_g, p.od_ln_b, p.out, nullptr, nullptr);
}

extern "C" void kernel_launch(void* const* d_in, const int* in_sizes, int n_in, void* d_out, int out_size, void* d_ws, size_t ws_size, hipStream_t stream) {
  constexpr size_t kDynLds = 156672 + 16;
  static int grid_blocks = 0;
  if (!grid_blocks) {
    int dev = 0, cus = 0, per_cu = 0;
    (void)hipGetDevice(&dev);
    (void)hipDeviceGetAttribute(&cus, hipDeviceAttributeMultiprocessorCount, dev);
    (void)hipFuncSetAttribute((const void*)mega, hipFuncAttributeMaxDynamicSharedMemorySize, (int)kDynLds);
    (void)hipOccupancyMaxActiveBlocksPerMultiprocessor(&per_cu, mega, 512, kDynLds);
    if (per_cu < 1) fprintf(stderr, "occupancy query says 0 blocks per CU\n");
    if (ws_size < WS_NEED) fprintf(stderr, "workspace too small: %zu < %zu\n", ws_size, WS_NEED);
    grid_blocks = cus < 256 ? cus : 256;
  }
  Params p{};
  const float* const* in = (const float* const*)d_in;
  p.x = in[0]; p.ev_w_in = in[1]; p.ev_pe_k = in[2]; p.ev_pe_v = in[3]; p.ev_w1_k = in[4]; p.ev_w2_k = in[5]; p.ev_w1_v = in[6]; p.ev_w2_v = in[7];
  p.ev_w_out = in[8]; p.ev_ln_g = in[9]; p.ev_ln_b = in[10]; p.od_w_in = in[11]; p.od_lq1 = in[12]; p.od_lk1 = in[13]; p.od_lq2 = in[14]; p.od_lk2 = in[15];
  p.od_gn_g = in[16]; p.od_w_out = in[17]; p.od_ln_g = in[18]; p.od_ln_b = in[19]; p.out = (float*)d_out; p.ws = (char*)d_ws;
  (void)hipMemsetAsync((char*)d_ws + OFF_CNT, 0, 256 + XCD_BAR_WORDS * 4, stream);
  void* args[] = {&p};
  hipError_t e = hipLaunchCooperativeKernel((void*)mega, dim3(grid_blocks), dim3(512), args, kDynLds, stream);
  if (e != hipSuccess) fprintf(stderr, "cooperative launch failed: %s (grid %d)\n", hipGetErrorString(e), grid_blocks);
}
```

```cpp
#include <hip/hip_runtime.h>
#include <hip/hip_cooperative_groups.h>
#include <cstdio>
#include <cstdint>
namespace cg = cooperative_groups;

#define LAS __attribute__((address_space(3)))
#define PG8_LAS LAS
#define DI __device__ __forceinline__
typedef unsigned short bf16_t;
typedef short bf16x8 __attribute__((ext_vector_type(8)));
typedef short s16x4 __attribute__((ext_vector_type(4)));
typedef float f32x2 __attribute__((ext_vector_type(2)));
typedef float f32x4 __attribute__((ext_vector_type(4)));
typedef float f32x16 __attribute__((ext_vector_type(16)));
typedef unsigned u32x2 __attribute__((ext_vector_type(2)));
typedef unsigned u32x4 __attribute__((ext_vector_type(4)));
typedef __bf16 bf16x2v __attribute__((ext_vector_type(2)));

DI int otid() { int t = threadIdx.x; asm volatile("" : "+v"(t)); return t; }
DI unsigned cvt2(float a, float b) { f32x2 v = {a, b}; bf16x2v r = __builtin_convertvector(v, bf16x2v); return __builtin_bit_cast(unsigned, r); }
DI float bf_lo(unsigned u) { return __uint_as_float(u << 16); }
DI float bf_hi(unsigned u) { return __uint_as_float(u & 0xffff0000u); }
DI float silu_f(float x) { return x / (1.0f + __expf(-x)); }
DI float sigmoid_f(float x) { return 1.0f / (1.0f + __expf(-x)); }

constexpr int SEQ = 4096, NTOK = 8192, DM = 2048, N0 = 7936, N1 = 8192, EV_IN = 7704;
constexpr int NB0 = 62, NB1 = 64;
#define HBLK(H, nblk, b, blk) ((H) + ((size_t)((b) * (nblk) + (blk)) * SEQ) * 128)
constexpr size_t MiB = 1u << 20;
constexpr size_t OFF_A = 0, OFF_B = 32 * MiB, OFF_BTO0 = 64 * MiB, OFF_BTO1 = 72 * MiB, OFF_D = 80 * MiB;
constexpr size_t OFF_W1KT = OFF_D, OFF_W1VT = OFF_D + MiB, OFF_COS = OFF_D + 2 * MiB, OFF_SIN = OFF_D + 3 * MiB;
constexpr size_t OFF_W2KT = OFF_D + 4 * MiB, OFF_W2VT = OFF_W2KT + 32768, OFF_KCMP = OFF_W2VT + 32768, OFF_VCMP = OFF_KCMP + 262144;
constexpr size_t OFF_SSQ = OFF_VCMP + 262144, OFF_CNT = OFF_SSQ + 524288;
constexpr size_t OFF_BAR = OFF_CNT + 256;
constexpr size_t OFF_E = 86 * MiB, OFF_QRAW = OFF_E + 126 * MiB, WS_NEED = OFF_E + 142 * MiB;
constexpr float ALPHA = 1.41421356237309515f;
constexpr float LAMBDA_INIT = 0.35550906759f;
constexpr float QK_C = 0.08838834764831845f * 1.4426950408889634f;

#ifndef REP_GEMM
#define REP_GEMM 1
#endif
#ifndef REP_P0
#define REP_P0 1
#endif
#ifndef REP_P2
#define REP_P2 1
#endif
#ifndef REP_LN
#define REP_LN 1
#endif
#ifndef REP_SYNC
#define REP_SYNC 0
#endif
#ifndef REP_P3
#define REP_P3 1
#endif
#ifndef REP_P7
#define REP_P7 1
#endif
struct Params {
  const float *x, *ev_w_in, *ev_pe_k, *ev_pe_v, *ev_w1_k, *ev_w2_k, *ev_w1_v, *ev_w2_v, *ev_w_out, *ev_ln_g, *ev_ln_b;
  const float *od_w_in, *od_lq1, *od_lk1, *od_lq2, *od_lk2, *od_gn_g, *od_w_out, *od_ln_g, *od_ln_b;
  float* out; char* ws;
};

namespace pg8 {
constexpr int BM = 256, BK = 64, HALF = 128, HTB = HALF * BK * 2, STAGE_BYTES = 8 * HTB, NXCD = 8, WGM = 8;
DI int lds_byte(int r, int c) { const int st = (r >> 4) * 2 + (c >> 5), rr = r & 15, cc = c & 31, ob = rr * 64 + cc * 2; return st * 1024 + (ob ^ (((ob >> 9) & 1) << 5)); }
DI void stage_rc(int b, int& R, int& C) { const int st = b / 1024, sb = b % 1024, swz = sb ^ (((sb >> 9) & 1) << 5); R = (st >> 1) * 16 + swz / 64; C = (st & 1) * 32 + (swz % 64) / 2; }
DI int perm32(int rho) { const int n = rho >> 4, i = rho & 15; return 8 * (i >> 2) + 4 * n + (i & 3); }
struct Unit { int pm, pn; };
struct Gemm { const bf16_t* A; const bf16_t* Bt; int M, N, K; };
struct StaticOrder {
    int nM, nN, nwg, G, c;
    DI void init(int M, int N, int G_, int c_) { nM = M / BM; nN = N / BM; nwg = nM * nN; G = G_; c = c_; }
    DI bool next(int i, Unit& u) const {
        const long L = (long)i * G + c; if (L >= nwg) return false;
        int wgid = (int)L; { const int q = nwg / NXCD, r = nwg % NXCD, xcd = wgid % NXCD, off = wgid / NXCD; wgid = (xcd < r ? xcd * (q + 1) : r * (q + 1) + (xcd - r) * q) + off; }
        const int nig = WGM * nN, gid = wgid / nig, fm = gid * WGM, gsz = (nM - fm) < WGM ? (nM - fm) : WGM;
        u.pm = fm + ((wgid % nig) % gsz); u.pn = (wgid % nig) / gsz; return true;
    }
    DI void a_ready(const Unit&) const {}
    DI void done(const Unit&) const {}
};
struct EpiH {
    static constexpr bool PERM = true, AFTER_DRAIN = false;
    bf16_t* H; int ldc; bf16_t* raw; int ldraw; const float* cosT; const float* sinT; unsigned rope_mask_lo; int rope_upto; int raw_upto;
    DI void operator()(const f32x4 (&acc)[2][2][4][2], const Unit& u, int wr, int wc, int fr, int fq) const {
        const int row0 = u.pm * BM + wr * 64 + fr, col0 = u.pn * BM + wc * 32 + 8 * fq;
        const bool rope = (u.pn < rope_upto) || ((rope_mask_lo >> u.pn) & 1u), wraw = u.pn < raw_upto;
#pragma unroll
        for (int ai = 0; ai < 2; ++ai)
#pragma unroll
            for (int m = 0; m < 4; ++m) { const int row = row0 + ai * HALF + m * 16; const int t = row & (SEQ - 1);
#pragma unroll
                for (int bj = 0; bj < 2; ++bj) { f32x4 v0 = acc[ai][bj][m][0], v1 = acc[ai][bj][m][1]; const int col = col0 + bj * HALF;
                    if (wraw) { u32x4 w; w.x = cvt2(v0[0], v0[1]); w.y = cvt2(v0[2], v0[3]); w.z = cvt2(v1[0], v1[1]); w.w = cvt2(v1[2], v1[3]); *(u32x4*)(raw + (size_t)row * ldraw + col) = w; }
                    if (rope) { const int i0 = (col & 127) >> 1; const f32x4 c = *(const f32x4*)(cosT + t * 64 + i0), s = *(const f32x4*)(sinT + t * 64 + i0);
                        f32x4 a0, a1;
                        a0[0] = v0[0] * c[0] - v0[1] * s[0]; a0[1] = v0[1] * c[0] + v0[0] * s[0]; a0[2] = v0[2] * c[1] - v0[3] * s[1]; a0[3] = v0[3] * c[1] + v0[2] * s[1];
                        a1[0] = v1[0] * c[2] - v1[1] * s[2]; a1[1] = v1[1] * c[2] + v1[0] * s[2]; a1[2] = v1[2] * c[3] - v1[3] * s[3]; a1[3] = v1[3] * c[3] + v1[2] * s[3];
                        v0 = a0; v1 = a1; }
                    u32x4 w; w.x = cvt2(v0[0], v0[1]); w.y = cvt2(v0[2], v0[3]); w.z = cvt2(v1[0], v1[1]); w.w = cvt2(v1[2], v1[3]);
                    *(u32x4*)(H + ((size_t)((row >> 12) * ldc + (col >> 7)) * SEQ + t) * 128 + (col & 127)) = w; } }
    }
};
struct EpiRes {
    static constexpr bool PERM = false, AFTER_DRAIN = false;
    float* R; const float* xres; int ldc;
    DI void operator()(const f32x4 (&acc)[2][2][4][2], const Unit& u, int wr, int wc, int fr, int fq) const {
        const int row0 = u.pm * BM + wr * 64 + fr, col0 = u.pn * BM + wc * 32 + 4 * fq;
#pragma unroll
        for (int ai = 0; ai < 2; ++ai)
#pragma unroll
            for (int m = 0; m < 4; ++m) { const size_t off = (size_t)(row0 + ai * HALF + m * 16) * ldc + col0;
#pragma unroll
                for (int bj = 0; bj < 2; ++bj)
#pragma unroll
                    for (int n = 0; n < 2; ++n) { const f32x4 xr = *(const f32x4*)(xres + off + bj * HALF + n * 16); *(f32x4*)(R + off + bj * HALF + n * 16) = acc[ai][bj][m][n] + xr * ALPHA; } }
    }
};
struct EpiRes1 {
    static constexpr bool PERM = false, AFTER_DRAIN = false;
    float* R; const float* R0; const float* stat; const float* g; const float* b; int ldc;
    DI void operator()(const f32x4 (&acc)[2][2][4][2], const Unit& u, int wr, int wc, int fr, int fq) const {
        const int row0 = u.pm * BM + wr * 64 + fr, col0 = u.pn * BM + wc * 32 + 4 * fq;
        f32x4 gv[2][2], bv[2][2];
#pragma unroll
        for (int bj = 0; bj < 2; ++bj)
#pragma unroll
            for (int n = 0; n < 2; ++n) { gv[bj][n] = *(const f32x4*)(g + col0 + bj * HALF + n * 16); bv[bj][n] = *(const f32x4*)(b + col0 + bj * HALF + n * 16); }
#pragma unroll
        for (int ai = 0; ai < 2; ++ai)
#pragma unroll
            for (int m = 0; m < 4; ++m) { const int row = row0 + ai * HALF + m * 16; const size_t off = (size_t)row * ldc + col0;
                const f32x2 ms = *(const f32x2*)(stat + 2 * row);
#pragma unroll
                for (int bj = 0; bj < 2; ++bj)
#pragma unroll
                    for (int n = 0; n < 2; ++n) { const f32x4 xr = *(const f32x4*)(R0 + off + bj * HALF + n * 16);
                        const f32x4 x1 = (xr - ms[0]) * ms[1] * gv[bj][n] + bv[bj][n]; *(f32x4*)(R + off + bj * HALF + n * 16) = acc[ai][bj][m][n] + x1 * ALPHA; } }
    }
};
template <class Epi, class Sched>
__device__ __forceinline__ void gemm_phase(PG8_LAS unsigned char* lds, const Gemm g, const Sched& S, const Epi& E) {
    const int tid = otid(), wid = __builtin_amdgcn_readfirstlane(tid >> 6), lane = tid & 63, wr = wid >> 2, wc = wid & 3, fr = lane & 15, fq = lane >> 4;
    const int K = g.K, nt = K / BK;
    unsigned voffA[2], voffB[2];
#pragma unroll
    for (int i = 0; i < 2; ++i) { int R, C; stage_rc(tid * 16 + i * 8192, R, C); const int Rb = Epi::PERM ? ((R & ~31) + perm32(R & 31)) : R;
        voffA[i] = (unsigned)(R * K + C) * 2u; voffB[i] = (unsigned)(Rb * K + C) * 2u; }
    const size_t kstep = (size_t)(BK * 2);
    const size_t hstep = (size_t)HALF * K * 2;
    const size_t tstep = 2 * hstep;
    const unsigned ldsw = (unsigned)wid * 1024u;
    const int aoff = lds_byte(wr * 64 + fr, fq * 8), boff = lds_byte(wc * 32 + fr, fq * 8);
#define PG8_SA(b, h) (((b) * 2 + (h)) * HTB)
#define PG8_SB(b, h) ((4 + (b) * 2 + (h)) * HTB)
#define PG8_STAGE(bufoff, gbase, voff) do { _Pragma("unroll") for (int _i = 0; _i < 2; ++_i) \
        __builtin_amdgcn_global_load_lds((const unsigned*)((const char*)(gbase) + (voff)[_i]), (PG8_LAS unsigned*)(lds + (bufoff) + ldsw + _i * 8192), 16, 0, 0); } while (0)
#define PG8_LDA(dst, b, h) do { _Pragma("unroll") for (int m = 0; m < 4; ++m) _Pragma("unroll") for (int k = 0; k < 2; ++k) dst[m][k] = *(const PG8_LAS bf16x8*)(lds + PG8_SA(b, h) + aoff + m * 2048 + k * 1024); } while (0)
#define PG8_LDB(dst, b, h) do { _Pragma("unroll") for (int n = 0; n < 2; ++n) _Pragma("unroll") for (int k = 0; k < 2; ++k) dst[n][k] = *(const PG8_LAS bf16x8*)(lds + PG8_SB(b, h) + boff + n * 2048 + k * 1024); } while (0)
#define PG8_MMA(ai, bj, At, Bt) do { __builtin_amdgcn_s_setprio(1); _Pragma("unroll") for (int m = 0; m < 4; ++m) _Pragma("unroll") for (int n = 0; n < 2; ++n) _Pragma("unroll") for (int k = 0; k < 2; ++k) \
        acc[ai][bj][m][n] = __builtin_amdgcn_mfma_f32_16x16x32_bf16(Bt[n][k], At[m][k], acc[ai][bj][m][n], 0, 0, 0); __builtin_amdgcn_s_setprio(0); } while (0)
#define PG8_WAIT_V(n) asm volatile("s_waitcnt vmcnt(" #n ")" ::: "memory")
#define PG8_WAIT_L(n) asm volatile("s_waitcnt lgkmcnt(" #n ")" ::: "memory")
#define PG8_BAR __builtin_amdgcn_s_barrier()
#define PG8_SCHED __builtin_amdgcn_sched_barrier(0)
    Unit cur, nxt; int ui = 0;
    if (!S.next(0, cur)) return;
    f32x4 acc[2][2][4][2];
#pragma unroll
    for (int a = 0; a < 2; ++a)
#pragma unroll
        for (int b = 0; b < 2; ++b)
#pragma unroll
            for (int m = 0; m < 4; ++m)
#pragma unroll
                for (int n = 0; n < 2; ++n) acc[a][b][m][n] = (f32x4){0.f, 0.f, 0.f, 0.f};
    bf16x8 At[4][2], B0[2][2], B1[2][2];
    const char* cA = (const char*)g.A + (size_t)cur.pm * tstep; const char* cB = (const char*)g.Bt + (size_t)cur.pn * tstep;
    S.a_ready(cur);
    PG8_STAGE(PG8_SB(0, 0), cB, voffB); PG8_STAGE(PG8_SA(0, 0), cA, voffA); PG8_STAGE(PG8_SB(0, 1), cB + hstep, voffB); PG8_STAGE(PG8_SA(0, 1), cA + hstep, voffA);
    if (wr == 1) PG8_BAR;
    PG8_WAIT_V(4); PG8_BAR;
    PG8_STAGE(PG8_SB(1, 0), cB + kstep, voffB); PG8_STAGE(PG8_SA(1, 0), cA + kstep, voffA); PG8_STAGE(PG8_SB(1, 1), cB + hstep + kstep, voffB);
    PG8_WAIT_V(6); PG8_BAR;
    for (;;) {
        const bool has_next = S.next(ui + 1, nxt);
        const char* nA = has_next ? (const char*)g.A + (size_t)nxt.pm * tstep : cA; const char* nB = has_next ? (const char*)g.Bt + (size_t)nxt.pn * tstep : cB;
        for (int t = 0; t < nt; t += 2) {
            const bool last = (t == nt - 2);
            const char* a1 = cA + (size_t)(t + 1) * kstep;
            const char* a2 = last ? nA : cA + (size_t)(t + 2) * kstep; const char* b2 = last ? nB : cB + (size_t)(t + 2) * kstep;
            const char* a3 = a2 + kstep; const char* b3 = b2 + kstep;
            if (last && has_next) S.a_ready(nxt);
            PG8_LDB(B0, 0, 0); PG8_SCHED; PG8_LDA(At, 0, 0); PG8_STAGE(PG8_SA(1, 1), a1 + hstep, voffA);
            PG8_WAIT_L(8); PG8_BAR; PG8_WAIT_L(0); PG8_MMA(0, 0, At, B0); PG8_BAR; PG8_SCHED;
            PG8_LDB(B1, 0, 1); PG8_STAGE(PG8_SB(0, 0), b2, voffB);
            PG8_BAR; PG8_WAIT_L(0); PG8_MMA(0, 1, At, B1); PG8_BAR;
            PG8_LDA(At, 0, 1); PG8_STAGE(PG8_SA(0, 0), a2, voffA);
            PG8_BAR; PG8_WAIT_L(0); PG8_MMA(1, 0, At, B0); PG8_BAR; PG8_SCHED;
            PG8_STAGE(PG8_SB(0, 1), b2 + hstep, voffB);
            PG8_WAIT_V(6); PG8_BAR; PG8_MMA(1, 1, At, B1); PG8_BAR;
            PG8_LDB(B0, 1, 0); PG8_SCHED; PG8_LDA(At, 1, 0); PG8_STAGE(PG8_SA(0, 1), a2 + hstep, voffA);
            PG8_WAIT_L(8); PG8_BAR; PG8_WAIT_L(0); PG8_MMA(0, 0, At, B0); PG8_BAR; PG8_SCHED;
            PG8_LDB(B1, 1, 1); PG8_STAGE(PG8_SB(1, 0), b3, voffB);
            PG8_BAR; PG8_WAIT_L(0); PG8_MMA(0, 1, At, B1); PG8_BAR;
            PG8_LDA(At, 1, 1); PG8_STAGE(PG8_SA(1, 0), a3, voffA);
            PG8_BAR; PG8_WAIT_L(0); PG8_MMA(1, 0, At, B0); PG8_BAR; PG8_SCHED;
            PG8_STAGE(PG8_SB(1, 1), b3 + hstep, voffB);
            PG8_WAIT_V(6); PG8_BAR; PG8_MMA(1, 1, At, B1); PG8_BAR;
        }
        if constexpr (!Epi::AFTER_DRAIN) { E(acc, cur, wr, wc, fr, fq); S.done(cur); }
        if (!has_next) break;
#pragma unroll
        for (int a = 0; a < 2; ++a)
#pragma unroll
            for (int b = 0; b < 2; ++b)
#pragma unroll
                for (int m = 0; m < 4; ++m)
#pragma unroll
                    for (int n = 0; n < 2; ++n) acc[a][b][m][n] = (f32x4){0.f, 0.f, 0.f, 0.f};
        cur = nxt; cA = nA; cB = nB; ++ui;
    }
    PG8_WAIT_V(0);
    if (wr == 0) PG8_BAR;
    PG8_BAR;
    if constexpr (Epi::AFTER_DRAIN) { E.fused(acc, cur, wr, wc, fr, fq, lds, wid, lane); S.done(cur); }
#undef PG8_SA
#undef PG8_SB
#undef PG8_STAGE
#undef PG8_LDA
#undef PG8_LDB
#undef PG8_MMA
#undef PG8_WAIT_V
#undef PG8_WAIT_L
#undef PG8_BAR
#undef PG8_SCHED
}
}

DI int rope_perm(int n) { const int d = n & 127; return (n & ~127) + (d >> 1) + 64 * (d & 1); }
DI int colmap(int mode, int n) {
  if (mode == 0) return n;
  if (mode == 1) {
    if (n < 2560) { const bool rp = (n < 1024) || (n >= 1536 && n < 1792) || (n >= 2048 && n < 2304); return rp ? rope_perm(n) : n; }
    if (n < 7680) return n + 24;
    if (n < 7704) return n - 7680 + 2560;
    return -1; }
  if (mode == 2) return n < 4096 ? rope_perm(n) : n;
  return rope_perm(n);
}
DI void transpose_tile(const float* __restrict__ W, int ldw, int K, int mode, bf16_t* __restrict__ Bt, int n0, int k0, LAS float* tl  ) {
  const int tid = otid();
  int srcbase = n0, nvalid = 128; bool perm = false;
  if (mode == 1) { perm = (n0 < 1024) || n0 == 1536 || n0 == 1664 || n0 == 2048 || n0 == 2176;
    if (n0 >= 2560) { if (n0 < 7680) srcbase = n0 + 24; else if (n0 == 7680) { srcbase = 2560; nvalid = 24; } else { srcbase = 0; nvalid = 0; } } }
  else if (mode == 2) perm = n0 < 4096;
  else if (mode == 3) perm = true;
  const int c4 = tid & 31, kq = tid >> 5;
  f32x4 v[8];
#pragma unroll
  for (int j = 0; j < 8; ++j) { const int kk = kq + 16 * j;
    if (4 * c4 < nvalid) v[j] = *(const f32x4*)(W + (size_t)(k0 + kk) * ldw + srcbase + 4 * c4); else v[j] = (f32x4){0.f, 0.f, 0.f, 0.f}; }
#pragma unroll
  for (int j = 0; j < 8; ++j) { const int kk = kq + 16 * j;
#pragma unroll
    for (int e = 0; e < 4; ++e) { const int sj = 4 * c4 + e; const int dl = perm ? ((sj < 64) ? 2 * sj : 2 * (sj - 64) + 1) : sj; tl[dl * 129 + kk] = v[j][e]; } }
  __syncthreads();
  const int n2 = tid >> 2, kc = (tid & 3) * 32; const LAS float* r = tl + n2 * 129 + kc;
#pragma unroll
  for (int u = 0; u < 4; ++u) { u32x4 w; w.x = cvt2(r[8 * u], r[8 * u + 1]); w.y = cvt2(r[8 * u + 2], r[8 * u + 3]); w.z = cvt2(r[8 * u + 4], r[8 * u + 5]); w.w = cvt2(r[8 * u + 6], r[8 * u + 7]);
    *(u32x4*)(Bt + (size_t)(n0 + n2) * K + k0 + kc + 8 * u) = w; }
  __syncthreads();
}
DI void tr_matrix(const float* W, int ldw, int K, int N, int mode, bf16_t* Bt, int& base, int bid, int nb, LAS float* tl) {
  const int nk = K / 128, ntile = (N / 128) * nk;
  const int first = (((bid - base) % nb) + nb) % nb;
  for (int i = first; i < ntile; i += nb) { const int nt = i / nk, kt = i - nt * nk; transpose_tile(W, ldw, K, mode, Bt, nt * 128, kt * 128, tl); }
  base += ntile;
}

DI float wave_sum(float v) {
#pragma unroll
  for (int o = 32; o > 0; o >>= 1) v += __shfl_xor(v, o, 64);
  return v;
}
DI void ln_phase(const float* __restrict__ R, const float* __restrict__ g, const float* __restrict__ bta, float* __restrict__ outf, bf16_t* __restrict__ outb, float* __restrict__ stat) {
  const int tid = otid(), w = tid >> 6, lane = tid & 63;
  f32x4 gv[8], bv[8];
#pragma unroll
  for (int i = 0; i < 8; ++i) { gv[i] = ((const f32x4*)g)[lane + 64 * i]; bv[i] = ((const f32x4*)bta)[lane + 64 * i]; }
  for (int row = blockIdx.x * 8 + w; row < NTOK; row += gridDim.x * 8) {
    const f32x4* rp = (const f32x4*)(R + (size_t)row * DM); f32x4 v[8]; float s = 0.f;
#pragma unroll
    for (int i = 0; i < 8; ++i) { v[i] = rp[lane + 64 * i]; s += (v[i][0] + v[i][1]) + (v[i][2] + v[i][3]); }
    const float mu = wave_sum(s) * (1.0f / DM); float q = 0.f;
#pragma unroll
    for (int i = 0; i < 8; ++i) { v[i] = v[i] - mu; q += (v[i][0] * v[i][0] + v[i][1] * v[i][1]) + (v[i][2] * v[i][2] + v[i][3] * v[i][3]); }
    const float rstd = __builtin_amdgcn_rsqf(wave_sum(q) * (1.0f / DM) + 1e-5f);
    if (stat && lane == 0) { f32x2 ms = {mu, rstd}; *(f32x2*)(stat + 2 * row) = ms; }
#pragma unroll
    for (int i = 0; i < 8; ++i) { const f32x4 y = v[i] * rstd * gv[i] + bv[i]; if (outf) ((f32x4*)(outf + (size_t)row * DM))[lane + 64 * i] = y;
      if (outb) { u32x2 w2; w2.x = cvt2(y[0], y[1]); w2.y = cvt2(y[2], y[3]); ((u32x2*)(outb + (size_t)row * DM))[lane + 64 * i] = w2; } }
  }
}

#define MFMA32(a, b, c) __builtin_amdgcn_mfma_f32_32x32x16_bf16((a), (b), (c), 0, 0, 0)
DI void compress_block(const Params& p, int cb, LAS char* lds) {
  const int tid = otid(), w = __builtin_amdgcn_readfirstlane(tid >> 6), lane = tid & 63, r32 = lane & 31, hi = lane >> 5;
  const int tensor = cb >> 5, m0 = (cb & 31) * 32, kq = w;
  const bf16_t* H0 = (const bf16_t*)(p.ws + OFF_E);
  const bf16_t* W1T = (const bf16_t*)(p.ws + (tensor ? OFF_W1VT : OFF_W1KT));
  const bf16_t* W2T = (const bf16_t*)(p.ws + (tensor ? OFF_W2VT : OFF_W2KT));
  const float* pe = tensor ? p.ev_pe_v : p.ev_pe_k;
  bf16_t* outp = (bf16_t*)(p.ws + (tensor ? OFF_VCMP : OFF_KCMP));
  const int m = m0 + r32, bh = m >> 8, b = bh >> 1, hk = bh & 1, n = m & 255;
  const int colblk = (tensor ? 10 : 8) + hk;
  const bf16_t* w1r = W1T + (size_t)r32 * 4096 + 8 * hi;
  f32x16 acc[4];
#pragma unroll
  for (int j = 0; j < 4; ++j) for (int i = 0; i < 16; ++i) acc[j][i] = 0.f;
  for (int l = 4 * kq; l < 4 * kq + 4; ++l) {
    int tok = 16 * n + l; tok = tok > SEQ - 1 ? SEQ - 1 : tok;
    const bf16_t* src = HBLK(H0, NB0, b, colblk) + (size_t)tok * 128 + 8 * hi;
    const float* pel = pe + l * 128 + 8 * hi;
#pragma unroll
    for (int s8 = 0; s8 < 8; ++s8) {
      const u32x4 hv = *(const u32x4*)(src + 16 * s8);
      const f32x4 pa = *(const f32x4*)(pel + 16 * s8), pb = *(const f32x4*)(pel + 16 * s8 + 4);
      u32x4 fv; fv.x = cvt2(bf_lo(hv.x) + pa[0], bf_hi(hv.x) + pa[1]); fv.y = cvt2(bf_lo(hv.y) + pa[2], bf_hi(hv.y) + pa[3]);
      fv.z = cvt2(bf_lo(hv.z) + pb[0], bf_hi(hv.z) + pb[1]); fv.w = cvt2(bf_lo(hv.w) + pb[2], bf_hi(hv.w) + pb[3]);
      const bf16x8 bfrag = __builtin_bit_cast(bf16x8, fv);
#pragma unroll
      for (int j = 0; j < 4; ++j) { const bf16x8 af = *(const bf16x8*)(w1r + (size_t)(32 * j) * 4096 + l * 128 + 16 * s8); acc[j] = MFMA32(af, bfrag, acc[j]); }
    }
  }
  LAS bf16_t* hid = (LAS bf16_t*)lds;
  LAS float* red = (LAS float*)(lds + 16384);
  {
    const int slot = kq > 0 ? kq - 1 : 7;
#pragma unroll
    for (int j = 0; j < 4; ++j) { LAS float* r0 = red + ((slot * 4 + j) * 64 + lane) * 16;
#pragma unroll
      for (int q4 = 0; q4 < 4; ++q4) { f32x4 v0 = {acc[j][4 * q4], acc[j][4 * q4 + 1], acc[j][4 * q4 + 2], acc[j][4 * q4 + 3]}; *(LAS f32x4*)(r0 + 4 * q4) = v0; } }
  }
  __syncthreads();
  if (w < 4) { const int j = w;
#pragma unroll
    for (int q4 = 0; q4 < 4; ++q4) { f32x4 s0 = {0.f, 0.f, 0.f, 0.f};
#pragma unroll
      for (int k = 0; k < 7; ++k) { const LAS float* r0 = red + ((k * 4 + j) * 64 + lane) * 16; s0 = s0 + *(const LAS f32x4*)(r0 + 4 * q4); }
      const LAS float* rz = red + ((7 * 4 + j) * 64 + lane) * 16; s0 = s0 + *(const LAS f32x4*)(rz + 4 * q4);
      const int col = 32 * j + 8 * q4 + 4 * hi;
      u32x2 v; v.x = cvt2(silu_f(s0[0]), silu_f(s0[1])); v.y = cvt2(silu_f(s0[2]), silu_f(s0[3])); *(LAS u32x2*)(hid + r32 * 136 + col) = v; }
  }
  __syncthreads();
  if (w < 4) { const int ct = w;
    f32x16 acc2; for (int i = 0; i < 16; ++i) acc2[i] = 0.f;
#pragma unroll
    for (int s = 0; s < 8; ++s) { const bf16x8 afrag = *(const bf16x8*)(W2T + (32 * ct + r32) * 128 + 16 * s + 8 * hi);
      const bf16x8 bfrag = *(LAS bf16x8*)(hid + r32 * 136 + 16 * s + 8 * hi); acc2 = MFMA32(afrag, bfrag, acc2); }
#pragma unroll
    for (int q4 = 0; q4 < 4; ++q4) { const int col = 32 * ct + 8 * q4 + 4 * hi; u32x2 v; v.x = cvt2(acc2[4 * q4], acc2[4 * q4 + 1]); v.y = cvt2(acc2[4 * q4 + 2], acc2[4 * q4 + 3]);
      *(u32x2*)(outp + (size_t)m * 128 + col) = v; }
  }
  __syncthreads();
}

constexpr int KBUF = 16384, VROW = 320, VBUF = 64 * VROW;
constexpr int LDS_K0 = 0, LDS_V0 = 2 * KBUF, LDS_MISC = LDS_V0 + 2 * VBUF;
constexpr int LDS_IMP = LDS_MISC + 256, LDS_MASK = LDS_IMP + 64 * 65 * 4, LDS_Q = LDS_MASK + 512, LDS_ATT_END = LDS_Q + 65536, LDS_XB = LDS_ATT_END;
#define KSWZ(row, colB) ((row) * 256 + ((colB) ^ (((((row) & 7) | ((((row) >> 4) & 1) << 3))) << 4)))
DI int crow(int r, int hi) { return (r & 3) + 8 * (r >> 2) + 4 * hi; }
struct Stage { bf16x8 k0, k1, v0, v1; };
DI void stage_load(int tid, Stage& s, const bf16_t* __restrict__ Kg, int ldk, const bf16_t* __restrict__ Vg, int ldv, int key0) {
  const int row = tid >> 4, d8 = (tid & 15) * 8;
  s.k0 = *(const bf16x8*)(Kg + (size_t)(key0 + row) * ldk + d8); s.k1 = *(const bf16x8*)(Kg + (size_t)(key0 + 32 + row) * ldk + d8);
  s.v0 = *(const bf16x8*)(Vg + (size_t)(key0 + row) * ldv + d8); s.v1 = *(const bf16x8*)(Vg + (size_t)(key0 + 32 + row) * ldv + d8);
}
DI void stage_write(int tid, const Stage& s, LAS char* lds, int buf) {
  const int row = tid >> 4, cb = (tid & 15) * 16;
  *(LAS bf16x8*)(lds + LDS_K0 + buf * KBUF + KSWZ(row, cb)) = s.k0; *(LAS bf16x8*)(lds + LDS_K0 + buf * KBUF + KSWZ(row + 32, cb)) = s.k1;
  *(LAS bf16x8*)(lds + LDS_V0 + buf * VBUF + row * VROW + cb) = s.v0; *(LAS bf16x8*)(lds + LDS_V0 + buf * VBUF + (row + 32) * VROW + cb) = s.v1;
}
DI void load_q(LAS char* qs, const bf16_t* qrow  ) {
#pragma unroll
  for (int d0 = 0; d0 < 8; ++d0) *(LAS bf16x8*)(qs + 1024 * d0) = *(const bf16x8*)(qrow + 16 * d0);
}
DI void qkt(f32x16& p0, f32x16& p1, LAS char* Kb, LAS char* qs, int r32, int hi) {
  for (int i = 0; i < 16; ++i) { p0[i] = 0.f; p1[i] = 0.f; }
#pragma unroll
  for (int d0 = 0; d0 < 8; ++d0) { const int cb = (d0 * 16 + hi * 8) * 2;
    const bf16x8 a0 = *(LAS bf16x8*)(Kb + KSWZ(r32, cb)); const bf16x8 a1 = *(LAS bf16x8*)(Kb + KSWZ(32 + r32, cb));
    const bf16x8 qf = *(LAS bf16x8*)(qs + 1024 * d0);
    p0 = MFMA32(a0, qf, p0); p1 = MFMA32(a1, qf, p1); }
}
DI bf16x8 pack8(const f32x16& p, int base) {
  u32x4 w; w.x = cvt2(p[base], p[base + 1]); w.y = cvt2(p[base + 2], p[base + 3]); w.z = cvt2(p[base + 4], p[base + 5]); w.w = cvt2(p[base + 6], p[base + 7]);
  return __builtin_bit_cast(bf16x8, w);
}
DI void pv(f32x16 (&o)[4], LAS char* Vb, const f32x16& p0, const f32x16& p1, int lane) {
  bf16x8 pf[4]; pf[0] = pack8(p0, 0); pf[1] = pack8(p0, 8); pf[2] = pack8(p1, 0); pf[3] = pack8(p1, 8);
  const int hi = lane >> 5, i16 = lane & 15, q = i16 >> 2, pp = i16 & 3, blk = (lane >> 4) & 1;
  LAS char* vb = Vb + (4 * hi + q) * VROW + (16 * blk + 4 * pp) * 2;
#pragma unroll
  for (int db = 0; db < 4; ++db) {
    __builtin_amdgcn_sched_barrier(0);
#pragma unroll
    for (int s = 0; s < 4; ++s) {
      const s16x4 lo = __builtin_amdgcn_ds_read_tr16_b64_v4i16((LAS s16x4*)(vb + (16 * s) * VROW + 64 * db));
      const s16x4 hh = __builtin_amdgcn_ds_read_tr16_b64_v4i16((LAS s16x4*)(vb + (16 * s + 8) * VROW + 64 * db));
      const bf16x8 vf = __builtin_shufflevector(lo, hh, 0, 1, 2, 3, 4, 5, 6, 7);
      o[db] = MFMA32(vf, pf[s], o[db]);
    }
  }
  __builtin_amdgcn_sched_barrier(0);
}
DI float pair_max(float v) { const auto rr = __builtin_amdgcn_permlane32_swap(__float_as_uint(v), __float_as_uint(v), false, false); return fmaxf(__uint_as_float(rr[0]), __uint_as_float(rr[1])); }
DI float pair_sum(float v) { const auto rr = __builtin_amdgcn_permlane32_swap(__float_as_uint(v), __float_as_uint(v), false, false); return __uint_as_float(rr[0]) + __uint_as_float(rr[1]); }
DI void softmax_tile(f32x16& p0, f32x16& p1, int lo, int hh, bool lane_on, bool elem_mask, float& m_run, float& l_run, f32x16 (&o)[4], int hi) {
  const float NINF = -__builtin_inff();
  if (elem_mask) {
#pragma unroll
    for (int r = 0; r < 16; ++r) { const int kk = crow(r, hi); const bool v0 = kk >= lo && kk <= hh, v1 = (kk + 32) >= lo && (kk + 32) <= hh;
      p0[r] = v0 ? p0[r] : NINF; p1[r] = v1 ? p1[r] : NINF; }
  }
  float pm = fmaxf(p0[0], p1[0]);
#pragma unroll
  for (int r = 1; r < 16; ++r) pm = fmaxf(fmaxf(pm, p0[r]), p1[r]);
  pm = lane_on ? pm : NINF;
  pm = pair_max(pm) * QK_C;
  if (!__all(pm <= m_run + 8.0f)) {
    const float mn = fmaxf(m_run, pm), alpha = __builtin_amdgcn_exp2f(m_run - mn); m_run = mn; l_run *= alpha;
#pragma unroll
    for (int db = 0; db < 4; ++db)
#pragma unroll
      for (int r = 0; r < 16; ++r) o[db][r] *= alpha;
  }
  const float nm = lane_on ? -m_run : NINF;
  float ls = 0.f;
#pragma unroll
  for (int r = 0; r < 16; ++r) { p0[r] = __builtin_amdgcn_exp2f(fmaf(p0[r], QK_C, nm)); ls += p0[r]; }
#pragma unroll
  for (int r = 0; r < 16; ++r) { p1[r] = __builtin_amdgcn_exp2f(fmaf(p1[r], QK_C, nm)); ls += p1[r]; }
  l_run += ls;
}
#define WBAR() do { asm volatile("s_waitcnt lgkmcnt(0)" ::: "memory"); __builtin_amdgcn_s_barrier(); asm volatile("" ::: "memory"); } while (0)
#define FP_COMPUTE(J, BUF) do { \
    const int tile_ = tile0 + (J), key0_ = tile_ * 64; \
    const bool lsel_ = (sel >> tile_) & 1ull; const int lo_ = klo - key0_, hh_ = khi - key0_; \
    const bool on_ = lsel_ && hh_ >= 0 && lo_ <= 63, fullv_ = lo_ <= 0 && hh_ >= 63; \
    f32x16 p0, p1; \
    qkt(p0, p1, lds + LDS_K0 + (BUF) * KBUF, qs, r32, hi); \
    softmax_tile(p0, p1, lo_, hh_, on_, __any(on_ && !fullv_), m_run, l_run, o, hi); \
    pv(o, lds + LDS_V0 + (BUF) * VBUF, p0, p1, lane); \
  } while (0)
DI void flash_pass(int tid, const bf16_t* Kg, int ldk, const bf16_t* Vg, int ldv, int tile0, int ntiles, LAS char* qs,
                   int klo, int khi, unsigned long long sel, f32x16 (&o)[4], float& m_run, float& l_run, LAS char* lds) {
  const int lane = tid & 63, r32 = lane & 31, hi = lane >> 5;
  const int first = tile0 * 64, last = (tile0 + ntiles - 1) * 64;
  Stage sA, sB;
  stage_load(tid, sA, Kg, ldk, Vg, ldv, first); stage_write(tid, sA, lds, 0);
  { const int k = first + 64; stage_load(tid, sA, Kg, ldk, Vg, ldv, k < last ? k : last); }
  { const int k = first + 128; stage_load(tid, sB, Kg, ldk, Vg, ldv, k < last ? k : last); }
  WBAR();
  for (int it = 0; it < ntiles; it += 2) {
    FP_COMPUTE(it, 0);
    stage_write(tid, sA, lds, 1);
    { const int k = first + (it + 3) * 64; stage_load(tid, sA, Kg, ldk, Vg, ldv, k < last ? k : last); }
    WBAR();
    if (it + 1 < ntiles) FP_COMPUTE(it + 1, 1);
    stage_write(tid, sB, lds, 0);
    { const int k = first + (it + 4) * 64; stage_load(tid, sB, Kg, ldk, Vg, ldv, k < last ? k : last); }
    WBAR();
  }
  __syncthreads();
}
constexpr int K2BUF = 8192, V2ROW = 576, V2BUF = 32 * V2ROW, LDS2_K0 = 0, LDS2_V0 = 2 * K2BUF;
struct Stage2 { bf16x8 k0, v0, v1; };
DI void stage2_load(int tid, Stage2& s, const bf16_t* __restrict__ Kg, int ldk, const bf16_t* __restrict__ Vg, int ldv, int key0) {
  s.k0 = *(const bf16x8*)(Kg + (size_t)(key0 + (tid >> 4)) * ldk + (tid & 15) * 8);
  const bf16_t* vp = Vg + (size_t)((tid >> 4) & 1) * SEQ * 128 + (tid & 15) * 8;
  s.v0 = *(const bf16x8*)(vp + (size_t)(key0 + (tid >> 5)) * ldv);
  s.v1 = *(const bf16x8*)(vp + (size_t)(key0 + 16 + (tid >> 5)) * ldv);
}
DI void stage2_write(int tid, const Stage2& s, LAS char* lds, int buf) {
  *(LAS bf16x8*)(lds + LDS2_K0 + buf * K2BUF + KSWZ(tid >> 4, (tid & 15) * 16)) = s.k0;
  *(LAS bf16x8*)(lds + LDS2_V0 + buf * V2BUF + (tid >> 5) * V2ROW + (tid & 31) * 16) = s.v0;
  *(LAS bf16x8*)(lds + LDS2_V0 + buf * V2BUF + (16 + (tid >> 5)) * V2ROW + (tid & 31) * 16) = s.v1;
}
#define F256_COMPUTE(IT, BUF) do { \
    const int hh = t - (IT) * 32; \
    f32x16 p0; for (int i = 0; i < 16; ++i) p0[i] = 0.f; \
    LAS char* Kb = lds + LDS2_K0 + (BUF) * K2BUF; \
    _Pragma("unroll") for (int d0 = 0; d0 < 8; ++d0) { const int cb = (d0 * 16 + hi * 8) * 2; const bf16x8 a0 = *(LAS bf16x8*)(Kb + KSWZ(r32, cb)); const bf16x8 qf = *(LAS bf16x8*)(qs + 1024 * d0); p0 = MFMA32(a0, qf, p0); } \
    if (!__all(hh >= 31)) { _Pragma("unroll") for (int r = 0; r < 16; ++r) p0[r] = crow(r, hi) <= hh ? p0[r] : NINF; } \
    float pm = p0[0]; \
    _Pragma("unroll") for (int r = 1; r < 16; ++r) pm = fmaxf(pm, p0[r]); \
    pm = pair_max(pm) * QK_C; \
    if (!__all(pm <= m_run + 8.0f)) { \
      const float mn = fmaxf(m_run, pm), alpha = __builtin_amdgcn_exp2f(m_run - mn); m_run = mn; l_run *= alpha; \
      _Pragma("unroll") for (int db = 0; db < 8; ++db) _Pragma("unroll") for (int r = 0; r < 16; ++r) o[db][r] *= alpha; } \
    const float nm = -m_run; float ls = 0.f; \
    _Pragma("unroll") for (int r = 0; r < 16; ++r) { p0[r] = __builtin_amdgcn_exp2f(fmaf(p0[r], QK_C, nm)); ls += p0[r]; } \
    l_run += ls; \
    bf16x8 pf[2]; pf[0] = pack8(p0, 0); pf[1] = pack8(p0, 8); \
    LAS char* vb = lds + LDS2_V0 + (BUF) * V2BUF + (4 * hi + q) * V2ROW + (16 * blk + 4 * pp) * 2; \
    _Pragma("unroll") for (int db = 0; db < 8; ++db) { \
      __builtin_amdgcn_sched_barrier(0); \
      _Pragma("unroll") for (int s2 = 0; s2 < 2; ++s2) { \
        const s16x4 lo = __builtin_amdgcn_ds_read_tr16_b64_v4i16((LAS s16x4*)(vb + (16 * s2) * V2ROW + 64 * db)); \
        const s16x4 h2 = __builtin_amdgcn_ds_read_tr16_b64_v4i16((LAS s16x4*)(vb + (16 * s2 + 8) * V2ROW + 64 * db)); \
        const bf16x8 vf = __builtin_shufflevector(lo, h2, 0, 1, 2, 3, 4, 5, 6, 7); \
        o[db] = MFMA32(vf, pf[s2], o[db]); } } \
    __builtin_amdgcn_sched_barrier(0); \
  } while (0)
DI void flash256_pass(int tid, const bf16_t* Kg, int ldk, const bf16_t* Vg, int ldv, int ntiles, LAS char* qs, int t, f32x16 (&o)[8], float& m_run, float& l_run, LAS char* lds) {
  const int lane = tid & 63, r32 = lane & 31, hi = lane >> 5;
  const int i16 = lane & 15, q = i16 >> 2, pp = i16 & 3, blk = (lane >> 4) & 1;
  const float NINF = -__builtin_inff();
  Stage2 sA, sB;
  const int last = (ntiles - 1) * 32;
  stage2_load(tid, sA, Kg, ldk, Vg, ldv, 0); stage2_write(tid, sA, lds, 0);
  stage2_load(tid, sA, Kg, ldk, Vg, ldv, 32);
  stage2_load(tid, sB, Kg, ldk, Vg, ldv, 64);
  WBAR();
  for (int it = 0; it < ntiles; it += 2) {
    F256_COMPUTE(it, 0);
    stage2_write(tid, sA, lds, 1);
    { const int k = (it + 3) * 32; stage2_load(tid, sA, Kg, ldk, Vg, ldv, k < last ? k : last); }
    WBAR();
    F256_COMPUTE(it + 1, 1);
    stage2_write(tid, sB, lds, 0);
    { const int k = (it + 4) * 32; stage2_load(tid, sB, Kg, ldk, Vg, ldv, k < last ? k : last); }
    WBAR();
  }
  __syncthreads();
}
#define LADD(ptr, v) __hip_atomic_fetch_add((ptr), (v), __ATOMIC_RELAXED, __HIP_MEMORY_SCOPE_WORKGROUP)
DI void cmp_importance(int tid, const bf16_t* Kg, int ntiles, LAS char* qs, int khi, float m_fin, float inv_l, int tl, LAS char* lds) {
  const int lane = tid & 63, r32 = lane & 31, hi = lane >> 5;
  LAS int* imp = (LAS int*)(lds + LDS_IMP) + tl * 65;
  const float NINF = -__builtin_inff();
  Stage st;
  stage_load(tid, st, Kg, 128, Kg, 128, 0); stage_write(tid, st, lds, 0); __syncthreads();
  for (int it = 0; it < ntiles; ++it) {
    const int key0 = it * 64, buf = it & 1;
    if (it + 1 < ntiles) stage_load(tid, st, Kg, 128, Kg, 128, key0 + 64);
    const int hh = khi - key0;
    if (__any(hh >= 0)) {
      f32x16 p0, p1; qkt(p0, p1, lds + LDS_K0 + buf * KBUF, qs, r32, hi);
#pragma unroll
      for (int r = 0; r < 16; ++r) { const int kk = crow(r, hi);
        p0[r] = kk <= hh ? __builtin_amdgcn_exp2f(fmaf(p0[r], QK_C, -m_fin)) * inv_l : 0.f;
        p1[r] = (kk + 32) <= hh ? __builtin_amdgcn_exp2f(fmaf(p1[r], QK_C, -m_fin)) * inv_l : 0.f; }
#pragma unroll
      for (int q = 0; q < 4; ++q) {
        const float a0 = (p0[4 * q] + p0[4 * q + 1]) + (p0[4 * q + 2] + p0[4 * q + 3]), a1 = (p1[4 * q] + p1[4 * q + 1]) + (p1[4 * q + 2] + p1[4 * q + 3]);
        const int g0 = 16 * it + 2 * q + hi, g1 = g0 + 8;
        LADD(imp + g0, (int)(a0 * 67108864.0f + 0.5f)); LADD(imp + g1, (int)(a1 * 67108864.0f + 0.5f));
        LADD(imp + g0 + 1, (int)(p0[4 * q + 3] * 67108864.0f + 0.5f));
        if (g1 + 1 < 64) LADD(imp + g1 + 1, (int)(p1[4 * q + 3] * 67108864.0f + 0.5f));
      }
    }
    if (it + 1 < ntiles) stage_write(tid, st, lds, buf ^ 1);
    __syncthreads();
  }
  (void)NINF;
}
DI void sb_pass(int tid, const bf16_t* Kg, int ldk, const bf16_t* Vg, int ldv, int tile_hi, LAS char* qs, int t, f32x16 (&o)[4], LAS char* lds) {
  const int lane = tid & 63, w = __builtin_amdgcn_readfirstlane(tid >> 6), r32 = lane & 31, hi = lane >> 5;
  LAS int* flags = (LAS int*)(lds + LDS_MISC);
  const float NINF = -__builtin_inff();
  float carry = 0.f;
  Stage st;
  stage_load(tid, st, Kg, ldk, Vg, ldv, tile_hi * 64); stage_write(tid, st, lds, 0); __syncthreads();
  for (int it = 0;; ++it) {
    const int tile = tile_hi - it, key0 = tile * 64, buf = it & 1;
    const bool more = tile > 0;
    if (more) stage_load(tid, st, Kg, ldk, Vg, ldv, key0 - 64);
    const int hh = t - 1 - key0;
    if (__any(hh >= 0)) {
      f32x16 p0, p1; qkt(p0, p1, lds + LDS_K0 + buf * KBUF, qs, r32, hi);
      float l0[16], l1[16];
#pragma unroll
      for (int r = 0; r < 16; ++r) { const int kk = crow(r, hi);
        { const float Z = p0[r] * QK_C; const float sp = fmaxf(Z, 0.f) + __builtin_amdgcn_logf(1.0f + __builtin_amdgcn_exp2f(-fabsf(Z))); const bool v = kk <= hh; l0[r] = v ? -sp : 0.f; p0[r] = v ? Z - sp : NINF; }
        { const float Z = p1[r] * QK_C; const float sp = fmaxf(Z, 0.f) + __builtin_amdgcn_logf(1.0f + __builtin_amdgcn_exp2f(-fabsf(Z))); const bool v = (kk + 32) <= hh; l1[r] = v ? -sp : 0.f; p1[r] = v ? Z - sp : NINF; } }
      float run = 0.f;
#pragma unroll
      for (int q = 3; q >= 0; --q) { const float A = (l1[4 * q] + l1[4 * q + 1]) + (l1[4 * q + 2] + l1[4 * q + 3]); const float Ap = __shfl_xor(A, 32, 64);
        const float T = carry + run + (hi == 0 ? Ap : 0.f);
        const float e2 = l1[4 * q + 3], e1 = e2 + l1[4 * q + 2], e0 = e1 + l1[4 * q + 1];
        p1[4 * q + 3] = __builtin_amdgcn_exp2f(p1[4 * q + 3] + T); p1[4 * q + 2] = __builtin_amdgcn_exp2f(p1[4 * q + 2] + T + e2);
        p1[4 * q + 1] = __builtin_amdgcn_exp2f(p1[4 * q + 1] + T + e1); p1[4 * q] = __builtin_amdgcn_exp2f(p1[4 * q] + T + e0);
        run += A + Ap; }
#pragma unroll
      for (int q = 3; q >= 0; --q) { const float A = (l0[4 * q] + l0[4 * q + 1]) + (l0[4 * q + 2] + l0[4 * q + 3]); const float Ap = __shfl_xor(A, 32, 64);
        const float T = carry + run + (hi == 0 ? Ap : 0.f);
        const float e2 = l0[4 * q + 3], e1 = e2 + l0[4 * q + 2], e0 = e1 + l0[4 * q + 1];
        p0[4 * q + 3] = __builtin_amdgcn_exp2f(p0[4 * q + 3] + T); p0[4 * q + 2] = __builtin_amdgcn_exp2f(p0[4 * q + 2] + T + e2);
        p0[4 * q + 1] = __builtin_amdgcn_exp2f(p0[4 * q + 1] + T + e1); p0[4 * q] = __builtin_amdgcn_exp2f(p0[4 * q] + T + e0);
        run += A + Ap; }
      carry += run;
      pv(o, lds + LDS_V0 + buf * VBUF, p0, p1, lane);
    }
    const int wdone = __all(carry < -150.0f) ? 1 : 0;
    if (lane == 0) flags[(it & 1) * 8 + w] = wdone;
    if (more) stage_write(tid, st, lds, buf ^ 1);
    __syncthreads();
    int alld = 1;
#pragma unroll
    for (int i = 0; i < 8; ++i) alld &= flags[(it & 1) * 8 + i];
    if (!more || alld) break;
  }
  __syncthreads();
}

DI int next_item(int* counter, LAS char* lds) {
  LAS int* slot = (LAS int*)(lds + LDS_MISC + 128);
  if (threadIdx.x == 0) *slot = atomicAdd(counter, 1);
  __syncthreads(); const int v = __builtin_amdgcn_readfirstlane(*slot); __syncthreads(); return v;
}
DI void zero_o(f32x16 (&o)[4]) {
#pragma unroll
  for (int db = 0; db < 4; ++db)
#pragma unroll
    for (int r = 0; r < 16; ++r) o[db][r] = 0.f;
}
#define ST_NEXT(ptr) do { (ptr) += 2048; asm volatile("" : "+v"(ptr)); } while (0)
DI void stash_set(float* st, const f32x16 (&o)[4], float sc) {
#pragma unroll
  for (int db = 0; db < 4; ++db)
#pragma unroll
    for (int q4 = 0; q4 < 4; ++q4) { f32x4 v = {o[db][4 * q4] * sc, o[db][4 * q4 + 1] * sc, o[db][4 * q4 + 2] * sc, o[db][4 * q4 + 3] * sc}; *(f32x4*)st = v; ST_NEXT(st); }
}
DI void stash_add(float* st, const f32x16 (&o)[4], float sc) {
#pragma unroll
  for (int db = 0; db < 4; ++db)
#pragma unroll
    for (int q4 = 0; q4 < 4; ++q4) { f32x4 v = *(const f32x4*)st; v[0] += o[db][4 * q4] * sc; v[1] += o[db][4 * q4 + 1] * sc; v[2] += o[db][4 * q4 + 2] * sc; v[3] += o[db][4 * q4 + 3] * sc; *(f32x4*)st = v; ST_NEXT(st); }
}
DI void nsa_item(const Params& p, int item, LAS char* lds, float* stash) {
  const int tid = otid(), w = __builtin_amdgcn_readfirstlane(tid >> 6), lane = tid & 63, r32 = lane & 31, hi = lane >> 5;
  const int jc = 63 - (item >> 2), b = (item >> 1) & 1, hk = item & 1, g = w & 3, qh = w >> 2;
  const int t0 = jc * 64, tl = 32 * qh + r32, t = t0 + tl, head = hk * 4 + g; const size_t row = (size_t)b * SEQ + t;
  const bf16_t* H0 = (const bf16_t*)(p.ws + OFF_E);
  const bf16_t* Qraw = (const bf16_t*)(p.ws + OFF_QRAW);
  const bf16_t* Kc = (const bf16_t*)(p.ws + OFF_KCMP) + (size_t)(b * 2 + hk) * 256 * 128; const bf16_t* Vc = (const bf16_t*)(p.ws + OFF_VCMP) + (size_t)(b * 2 + hk) * 256 * 128;
  bf16_t* Ocat = (bf16_t*)(p.ws + OFF_A);
  float* st = stash + (size_t)blockIdx.x * 32768 + tid * 4;
  const bf16_t* gap = HBLK(H0, NB0, b, 60) + (size_t)t * 128 + head * 3;
  const float g0 = sigmoid_f(bf_lo((unsigned)gap[0])), g1 = sigmoid_f(bf_lo((unsigned)gap[1])), g2 = sigmoid_f(bf_lo((unsigned)gap[2]));
  LAS int* imp = (LAS int*)(lds + LDS_IMP); LAS unsigned* msk = (LAS unsigned*)(lds + LDS_MASK);
  for (int i = tid; i < 64 * 65; i += 512) imp[i] = 0;
  if (tid < 128) msk[tid] = 0u;
  LAS char* qs = lds + LDS_Q + w * 8192 + lane * 16; f32x16 o[4]; float m_run, l_run;
  load_q(qs, Qraw + row * 1024 + head * 128 + 8 * hi);
  const int nmax = t >= 31 ? (t - 31) >> 4 : -1;
  const int ncm = (((t0 + 63 - 31) >> 4) >> 6) + 1;
  zero_o(o); m_run = -1e30f; l_run = 0.f;
  flash_pass(tid, Kc, 128, Vc, 128, 0, ncm, qs, 0, nmax, ~0ull, o, m_run, l_run, lds);
  { const float lt = pair_sum(l_run), inv = lt > 0.f ? 1.0f / lt : 0.f; stash_set(st, o, inv * g0);
    if (jc >= 16) cmp_importance(tid, Kc, ncm, qs, nmax, m_run, inv, tl, lds); }
  unsigned long long sel = ~0ull;
  if (jc >= 16) {
    __syncthreads();
#pragma unroll 1
    for (int qi = 0; qi < 8; ++qi) { const int q = 8 * w + qi, j = lane;
      const bool forced = j == 0 || j == jc || j == jc - 1; const int sc = forced ? 0x7fffffff : (j <= jc ? imp[q * 65 + j] : -1);
      int rank = 0;
#pragma unroll
      for (int j2 = 0; j2 < 64; ++j2) { const int s2 = __builtin_amdgcn_readlane(sc, j2); rank += (s2 > sc || (s2 == sc && j2 < j)) ? 1 : 0; }
      const unsigned long long m = __ballot(rank < 16 && j <= jc);
      if (lane == 0) { msk[2 * q] = (unsigned)m; msk[2 * q + 1] = (unsigned)(m >> 32); } }
    __syncthreads();
    sel = (unsigned long long)msk[2 * tl] | ((unsigned long long)msk[2 * tl + 1] << 32);
  }
  load_q(qs, HBLK(H0, NB0, b, head) + (size_t)t * 128 + 8 * hi);
  zero_o(o); m_run = -1e30f; l_run = 0.f;
  flash_pass(tid, HBLK(H0, NB0, b, 12 + hk), 128, HBLK(H0, NB0, b, 14 + hk), 128, 0, jc + 1, qs, 0, t, sel, o, m_run, l_run, lds);
  { const float lt = pair_sum(l_run), inv = lt > 0.f ? 1.0f / lt : 0.f; stash_add(st, o, inv * g1); }
  const int wt0 = jc >= 8 ? jc - 8 : 0;
  zero_o(o); m_run = -1e30f; l_run = 0.f;
  flash_pass(tid, HBLK(H0, NB0, b, 16 + hk), 128, HBLK(H0, NB0, b, 18 + hk), 128, wt0, jc - wt0 + 1, qs, t - 511, t, ~0ull, o, m_run, l_run, lds);
  { const float lt = pair_sum(l_run), inv = (lt > 0.f ? 1.0f / lt : 0.f) * g2;
    const bf16_t* gate = HBLK(H0, NB0, b, 20 + head) + (size_t)t * 128; bf16_t* dst = Ocat + row * DM + head * 128; const float* stp = st;
#pragma unroll
    for (int db = 0; db < 4; ++db)
#pragma unroll
      for (int q4 = 0; q4 < 4; ++q4) { const int d = 32 * db + 8 * q4 + 4 * hi; const u32x2 gv = *(const u32x2*)(gate + d); float v[4];
        const f32x4 sv = *(const f32x4*)stp; ST_NEXT(stp);
#pragma unroll
        for (int i = 0; i < 4; ++i) v[i] = sv[i] + o[db][4 * q4 + i] * inv;
        u32x2 ov; ov.x = cvt2(v[0] * silu_f(bf_lo(gv.x)), v[1] * silu_f(bf_hi(gv.x))); ov.y = cvt2(v[2] * silu_f(bf_lo(gv.y)), v[3] * silu_f(bf_hi(gv.y)));
        *(u32x2*)(dst + d) = ov; } }
}
DI void sb_item(const Params& p, int idx, LAS char* lds) {
  const int tid = otid(), w = __builtin_amdgcn_readfirstlane(tid >> 6), lane = tid & 63, r32 = lane & 31, hi = lane >> 5;
  const int qb = 15 - (idx >> 4), b = (idx >> 3) & 1, h = idx & 7, t = 256 * qb + 32 * w + r32; const size_t row = (size_t)b * SEQ + t;
  const bf16_t* H0 = (const bf16_t*)(p.ws + OFF_E); bf16_t* Ocat = (bf16_t*)(p.ws + OFF_A);
  LAS char* qs = lds + LDS_Q + w * 8192 + lane * 16; f32x16 o[4]; load_q(qs, HBLK(H0, NB0, b, 28 + h) + (size_t)t * 128 + 8 * hi); zero_o(o);
  sb_pass(tid, HBLK(H0, NB0, b, 36 + h), 128, HBLK(H0, NB0, b, 44 + h), 128, 4 * qb + 3, qs, t, o, lds);
  const bf16_t* gate = HBLK(H0, NB0, b, 52 + h) + (size_t)t * 128; bf16_t* dst = Ocat + row * DM + 1024 + h * 128;
#pragma unroll
  for (int db = 0; db < 4; ++db)
#pragma unroll
    for (int q4 = 0; q4 < 4; ++q4) { const int d = 32 * db + 8 * q4 + 4 * hi; const u32x2 gv = *(const u32x2*)(gate + d);
      u32x2 ov; ov.x = cvt2(o[db][4 * q4] * silu_f(bf_lo(gv.x)), o[db][4 * q4 + 1] * silu_f(bf_hi(gv.x))); ov.y = cvt2(o[db][4 * q4 + 2] * silu_f(bf_lo(gv.y)), o[db][4 * q4 + 3] * silu_f(bf_hi(gv.y)));
      *(u32x2*)(dst + d) = ov; }
}
DI void diff_item(const Params& p, int item, LAS char* lds) {
  const int tid = otid(), w = __builtin_amdgcn_readfirstlane(tid >> 6), lane = tid & 63, r32 = lane & 31, hi = lane >> 5;
  const int qb = 15 - (item >> 5), b = (item >> 4) & 1, h = (item >> 1) & 7, c = item & 1, t = 256 * qb + 32 * w + r32; const size_t row = (size_t)b * SEQ + t;
  const bf16_t* H1 = (const bf16_t*)(p.ws + OFF_E);
  bf16_t* Oc = (bf16_t*)(p.ws + (c ? OFF_B : OFF_A));
  LAS char* qs = lds + LDS_Q + w * 8192 + lane * 16; f32x16 o[8]; float m_run = -1e30f, l_run = 0.f;
#pragma unroll
  for (int db = 0; db < 8; ++db)
#pragma unroll
    for (int r = 0; r < 16; ++r) o[db][r] = 0.f;
  load_q(qs, HBLK(H1, NB1, b, 2 * h + c) + (size_t)t * 128 + 8 * hi);
  flash256_pass(tid, HBLK(H1, NB1, b, 16 + 2 * h + c), 128, HBLK(H1, NB1, b, 32 + 2 * h), 128, 8 * qb + 8, qs, t, o, m_run, l_run, lds);
  const float lt = pair_sum(l_run), inv = lt > 0.f ? 1.0f / lt : 0.f;
  bf16_t* dst = Oc + row * DM + h * 256;
#pragma unroll
  for (int db = 0; db < 8; ++db)
#pragma unroll
    for (int q4 = 0; q4 < 4; ++q4) { const int d = 32 * db + 8 * q4 + 4 * hi;
      u32x2 ov; ov.x = cvt2(o[db][4 * q4] * inv, o[db][4 * q4 + 1] * inv); ov.y = cvt2(o[db][4 * q4 + 2] * inv, o[db][4 * q4 + 3] * inv); *(u32x2*)(dst + d) = ov; }
}

#define XB_TMO      128
#define XB_XCNT(j)  (256  + 64 * (j))
#define XB_XSUB(j)  (1280 + 64 * (j))
#define XB_XGEN(j)  (2304 + 64 * (j))
#define XB_TOP      3328
#define XB_TOPGEN   3392
#define XCD_BAR_WORDS 3456
#define XB_SPIN_CAP (1u << 18)
DI unsigned xb_ld(unsigned* p)              { return __hip_atomic_load(p, __ATOMIC_RELAXED, __HIP_MEMORY_SCOPE_AGENT); }
DI unsigned xb_add(unsigned* p, unsigned v) { return __hip_atomic_fetch_add(p, v, __ATOMIC_RELAXED, __HIP_MEMORY_SCOPE_AGENT); }
DI unsigned xb_xcc_id() { return (unsigned)__builtin_amdgcn_s_getreg((3 << 11) | 20) & 0xFu; }
#define XB_SPIN(cond, bar) do { unsigned _sp = 0; while (cond) { __builtin_amdgcn_s_sleep(1); \
    if ((++_sp & 255u) == 0u) { if (xb_ld(&(bar)[XB_TMO])) break; if (_sp > XB_SPIN_CAP) { atomicAdd(&(bar)[XB_TMO], 1u); break; } } } } while (0)
struct XcdBarrier { unsigned* bar; unsigned x; volatile LAS unsigned* st; };
DI XcdBarrier xcd_barrier_post(unsigned* bar, volatile LAS unsigned* st) {
    XcdBarrier b; b.bar = bar; b.x = xb_xcc_id(); b.st = st;
    if (threadIdx.x == 0) (void)xb_add(&bar[XB_XCNT(b.x)], 1u);
    return b;
}
DI void xcd_barrier_complete(unsigned* bar, unsigned x, unsigned& nloc, unsigned& nx) {
    const unsigned G = gridDim.x * gridDim.y * gridDim.z;
    unsigned sum, cntx, mine, sp = 0u;
    for (;;) {
        sum = 0u; cntx = 0u; mine = 0u;
#pragma unroll
        for (unsigned j = 0; j < 16; ++j) { const unsigned c = xb_ld(&bar[XB_XCNT(j)]); sum += c; cntx += (c > 0u) ? 1u : 0u; mine = (j == x) ? c : mine; }
        if (sum == G) break;
        __builtin_amdgcn_s_sleep(1);
        if ((++sp & 255u) == 0u) { if (xb_ld(&bar[XB_TMO])) break; if (sp > XB_SPIN_CAP) { atomicAdd(&bar[XB_TMO], 1u); break; } }
    }
    nloc = mine > 0u ? mine : 1u; nx = cntx > 0u ? cntx : 1u;
}
DI void xcd_barrier(const XcdBarrier& b) {
    asm volatile("s_waitcnt vmcnt(0)" ::: "memory");
    __syncthreads();
    if (threadIdx.x == 0) {
        unsigned* bar = b.bar;
        __builtin_amdgcn_s_waitcnt(0);
        unsigned nloc = b.st[0], nx = b.st[1];
        if (nloc == 0u) { xcd_barrier_complete(bar, b.x, nloc, nx); b.st[0] = nloc; b.st[1] = nx; }
        const unsigned old = xb_add(&bar[XB_XSUB(b.x)], 1u);
        const unsigned gen = old / nloc;
        if (old + 1u == (gen + 1u) * nloc) {
            __builtin_amdgcn_fence(__ATOMIC_RELEASE, "agent");
            asm volatile("s_waitcnt vmcnt(0)" ::: "memory");
            const unsigned og = xb_add(&bar[XB_TOP], 1u);
            const unsigned tg = og / nx;
            if (og + 1u == (tg + 1u) * nx) xb_add(&bar[XB_TOPGEN], 1u);
            else XB_SPIN(xb_ld(&bar[XB_TOPGEN]) == tg, bar);
            __builtin_amdgcn_fence(__ATOMIC_ACQUIRE, "agent");
            xb_add(&bar[XB_XGEN(b.x)], 1u);
            asm volatile("s_waitcnt vmcnt(0)" ::: "memory");
        } else {
            XB_SPIN(xb_ld(&bar[XB_XGEN(b.x)]) == gen, bar);
            __builtin_amdgcn_fence(__ATOMIC_ACQUIRE, "agent");
            asm volatile("s_waitcnt vmcnt(0)" ::: "memory");
        }
    }
    __syncthreads();
}

__global__ void __launch_bounds__(512) mega(Params p) {
  extern __shared__ __attribute__((aligned(16))) unsigned char shm[];
  LAS char* lds = (LAS char*)shm;
  cg::grid_group grid = cg::this_grid();
  const int bid = blockIdx.x, nb = gridDim.x;
  char* ws = p.ws;
  if (ws == nullptr) grid.sync();
  volatile LAS unsigned* xst = (volatile LAS unsigned*)(lds + LDS_XB);
  if (threadIdx.x == 0) { xst[0] = 0u; xst[1] = 0u; }
  __syncthreads();
  const XcdBarrier xbar = xcd_barrier_post((unsigned*)(ws + OFF_BAR), xst);
#define Xb ((bf16_t*)(ws + OFF_A))
#define cosT ((float*)(ws + OFF_COS))
#define sinT ((float*)(ws + OFF_SIN))
#define cnt ((int*)(ws + OFF_CNT))
#define lamp ((float*)(ws + OFF_CNT + 64))
#define PHASE_IDS int tid = threadIdx.x; asm volatile("" : "+v"(tid)); const size_t gtid = (size_t)bid * 512 + tid, gsz = (size_t)nb * 512; (void)gtid; (void)gsz;

  for (int rep0 = 0; rep0 < REP_P0; ++rep0) { PHASE_IDS
    for (size_t i = gtid; i < (size_t)NTOK * DM / 8; i += gsz) { const f32x4 a = ((const f32x4*)p.x)[2 * i], c = ((const f32x4*)p.x)[2 * i + 1];
      u32x4 w; w.x = cvt2(a[0], a[1]); w.y = cvt2(a[2], a[3]); w.z = cvt2(c[0], c[1]); w.w = cvt2(c[2], c[3]); ((u32x4*)Xb)[i] = w; }
    for (size_t i = gtid; i < (size_t)SEQ * 64; i += gsz) { const int t = (int)(i >> 6), f = (int)(i & 63);
      const float inv = (float)exp2(-(double)f * (13.287712379549449 / 64.0));
      const float ang = (float)t * inv; double rev = (double)ang * 0.15915494309189535; rev -= floor(rev); const float rf = (float)rev;
      cosT[i] = __builtin_amdgcn_cosf(rf); sinT[i] = __builtin_amdgcn_sinf(rf); }
    if (gtid == 0) { for (int i = 0; i < 8; ++i) cnt[i] = 0; float s1 = 0.f, s2 = 0.f; for (int i = 0; i < 128; ++i) { s1 += p.od_lq1[i] * p.od_lk1[i]; s2 += p.od_lq2[i] * p.od_lk2[i]; }
      lamp[0] = __expf(s1) - __expf(s2) + LAMBDA_INIT; }
    int base = 0; LAS float* tl = (LAS float*)lds;
    tr_matrix(p.ev_w_in, EV_IN, DM, N0, 1, (bf16_t*)(ws + OFF_B), base, bid, nb, tl);
    tr_matrix(p.ev_w1_k, 128, 4096, 128, 0, (bf16_t*)(ws + OFF_W1KT), base, bid, nb, tl);
    tr_matrix(p.ev_w1_v, 128, 4096, 128, 0, (bf16_t*)(ws + OFF_W1VT), base, bid, nb, tl);
    tr_matrix(p.ev_w2_k, 128, 128, 128, 3, (bf16_t*)(ws + OFF_W2KT), base, bid, nb, tl);
    tr_matrix(p.ev_w2_v, 128, 128, 128, 0, (bf16_t*)(ws + OFF_W2VT), base, bid, nb, tl);
  }
  xcd_barrier(xbar);
  { pg8::Gemm g{Xb, (const bf16_t*)(ws + OFF_B), NTOK, N0, DM}; pg8::StaticOrder S; S.init(NTOK, N0, nb, bid);
    pg8::EpiH E{(bf16_t*)(ws + OFF_E), NB0, (bf16_t*)(ws + OFF_QRAW), 1024, cosT, sinT, (1u << 6) | (1u << 8), 4, 4};
    for (int rep = 0; rep < REP_GEMM; ++rep) pg8::gemm_phase<pg8::EpiH, pg8::StaticOrder>((LAS unsigned char*)shm, g, S, E);
  }
  xcd_barrier(xbar);
  for (int rep2 = 0; rep2 < REP_P2; ++rep2)
  if (bid < 64) compress_block(p, bid, lds);
  xcd_barrier(xbar);
  for (int rep = 0; rep < REP_P3; ++rep) { if (rep) xcd_barrier(xbar);
  for (;;) { const int item = next_item(cnt + 2 * rep, lds); if (item >= 512 + 192) break;
    if (item >= 512) {
      LAS float* tl = (LAS float*)lds;
      for (int u = 0; u < 8; ++u) { const int ti = (item - 512) * 8 + u;
        if (ti < 1024) transpose_tile(p.od_w_in, N1, DM, 2, (bf16_t*)(ws + OFF_B), (ti >> 4) * 128, (ti & 15) * 128, tl);
        else if (ti < 1280) transpose_tile(p.od_w_out, DM, DM, 0, (bf16_t*)(ws + OFF_BTO1), ((ti - 1024) >> 4) * 128, ((ti - 1024) & 15) * 128, tl);
        else transpose_tile(p.ev_w_out, DM, DM, 0, (bf16_t*)(ws + OFF_BTO0), ((ti - 1280) >> 4) * 128, ((ti - 1280) & 15) * 128, tl); }
      continue; }
#ifndef SKIP_NSA
    if (item < 256) nsa_item(p, item, lds, p.out);
#endif
#ifndef SKIP_SB
    if (item >= 256) sb_item(p, item - 256, lds);
#endif
  } }
  xcd_barrier(xbar);
  { pg8::Gemm g{(const bf16_t*)(ws + OFF_A), (const bf16_t*)(ws + OFF_BTO0), NTOK, DM, DM}; pg8::StaticOrder S; S.init(NTOK, DM, nb, bid);
    pg8::EpiRes E{p.out, p.x, DM};
    for (int rep = 0; rep < REP_GEMM; ++rep) pg8::gemm_phase<pg8::EpiRes, pg8::StaticOrder>((LAS unsigned char*)shm, g, S, E);
  }
  xcd_barrier(xbar);
  for (int r = 0; r < REP_LN; ++r) ln_phase(p.out, p.ev_ln_g, p.ev_ln_b, nullptr, (bf16_t*)(ws + OFF_A), (float*)(ws + OFF_SSQ));
  for (int r = 0; r < REP_SYNC; ++r) xcd_barrier(xbar);
  xcd_barrier(xbar);
  { pg8::Gemm g{(const bf16_t*)(ws + OFF_A), (const bf16_t*)(ws + OFF_B), NTOK, N1, DM}; pg8::StaticOrder S; S.init(NTOK, N1, nb, bid);
    pg8::EpiH E{(bf16_t*)(ws + OFF_E), NB1, nullptr, 0, cosT, sinT, 0u, 16, 0};
    for (int rep = 0; rep < REP_GEMM; ++rep) pg8::gemm_phase<pg8::EpiH, pg8::StaticOrder>((LAS unsigned char*)shm, g, S, E);
  }
  xcd_barrier(xbar);
  {
    for (int rep = 0; rep < REP_P7; ++rep) { if (rep) xcd_barrier(xbar);
    for (;;) { const int item = next_item(cnt + 1 + 2 * rep, lds); if (item >= 512) break;
#ifndef SKIP_DIFF
      diff_item(p, item, lds);
#endif
    } } }
  xcd_barrier(xbar);
  { const int tid = otid(), w = tid >> 6, lane = tid & 63;
    const float lam = lamp[0];
    bf16_t* O0 = (bf16_t*)(ws + OFF_A); const bf16_t* O1 = (const bf16_t*)(ws + OFF_B); const bf16_t* H1 = (const bf16_t*)(ws + OFF_E);
    for (int pr = bid * 8 + w; pr < NTOK * 8; pr += nb * 8) { const size_t row = (size_t)(pr >> 3); const int h = pr & 7, c0 = h * 256 + 4 * lane;
      const u32x2 a = *(const u32x2*)(O0 + row * DM + c0), bq = *(const u32x2*)(O1 + row * DM + c0), gv = *(const u32x2*)(HBLK(H1, NB1, (int)(row >> 12), 48 + 2 * h + (lane >> 5)) + (size_t)(row & 4095) * 128 + ((4 * lane) & 127));
      const f32x4 gn = *(const f32x4*)(p.od_gn_g + c0);
      float u[4] = {bf_lo(a.x) - lam * bf_lo(bq.x), bf_hi(a.x) - lam * bf_hi(bq.x), bf_lo(a.y) - lam * bf_lo(bq.y), bf_hi(a.y) - lam * bf_hi(bq.y)};
      const float ss = wave_sum((u[0] * u[0] + u[1] * u[1]) + (u[2] * u[2] + u[3] * u[3]));
      const float r = __builtin_amdgcn_rsqf(ss * (1.0f / 256.0f) + 1e-5f) * (1.0f - LAMBDA_INIT);
      u32x2 ov; ov.x = cvt2(u[0] * r * gn[0] * silu_f(bf_lo(gv.x)), u[1] * r * gn[1] * silu_f(bf_hi(gv.x))); ov.y = cvt2(u[2] * r * gn[2] * silu_f(bf_lo(gv.y)), u[3] * r * gn[3] * silu_f(bf_hi(gv.y)));
      *(u32x2*)(O0 + row * DM + c0) = ov; } }
  xcd_barrier(xbar);
  { pg8::Gemm g{(const bf16_t*)(ws + OFF_A), (const bf16_t*)(ws + OFF_BTO1), NTOK, DM, DM}; pg8::StaticOrder S; S.init(NTOK, DM, nb, bid);
    pg8::EpiRes1 E{(float*)(ws + OFF_E), p.out, (const float*)(ws + OFF_SSQ), p.ev_ln_g, p.ev_ln_b, DM};
    for (int rep = 0; rep < REP_GEMM; ++rep) pg8::gemm_phase<pg8::EpiRes1, pg8::StaticOrder>((LAS unsigned char*)shm, g, S, E);
  }
  xcd_barrier(xbar);
  for (int r = 0; r < REP_LN; ++r) ln_phase((const float*)(ws + OFF_E), p.od_ln_g, p.od_ln_b, p.out, nullptr, nullptr);
}

extern "C" void kernel_launch(void* const* d_in, const int* in_sizes, int n_in, void* d_out, int out_size, void* d_ws, size_t ws_size, hipStream_t stream) {
  constexpr size_t kDynLds = 156672 + 16;
  static int grid_blocks = 0;
  if (!grid_blocks) {
    int dev = 0, cus = 0, per_cu = 0;
    (void)hipGetDevice(&dev);
    (void)hipDeviceGetAttribute(&cus, hipDeviceAttributeMultiprocessorCount, dev);
    (void)hipFuncSetAttribute((const void*)mega, hipFuncAttributeMaxDynamicSharedMemorySize, (int)kDynLds);
    (void)hipOccupancyMaxActiveBlocksPerMultiprocessor(&per_cu, mega, 512, kDynLds);
    if (per_cu < 1) fprintf(stderr, "occupancy query says 0 blocks per CU\n");
    if (ws_size < WS_NEED) fprintf(stderr, "workspace too small: %zu < %zu\n", ws_size, WS_NEED);
    grid_blocks = cus < 256 ? cus : 256;
  }
  Params p{};
  const float* const* in = (const float* const*)d_in;
  p.x = in[0]; p.ev_w_in = in[1]; p.ev_pe_k = in[2]; p.ev_pe_v = in[3]; p.ev_w1_k = in[4]; p.ev_w2_k = in[5]; p.ev_w1_v = in[6]; p.ev_w2_v = in[7];
  p.ev_w_out = in[8]; p.ev_ln_g = in[9]; p.ev_ln_b = in[10]; p.od_w_in = in[11]; p.od_lq1 = in[12]; p.od_lk1 = in[13]; p.od_lq2 = in[14]; p.od_lk2 = in[15];
  p.od_gn_g = in[16]; p.od_w_out = in[17]; p.od_ln_g = in[18]; p.od_ln_b = in[19]; p.out = (float*)d_out; p.ws = (char*)d_ws;
  (void)hipMemsetAsync((char*)d_ws + OFF_CNT, 0, 256 + XCD_BAR_WORDS * 4, stream);
  void* args[] = {&p};
  hipError_t e = hipLaunchCooperativeKernel((void*)mega, dim3(grid_blocks), dim3(512), args, kDynLds, stream);
  if (e != hipSuccess) fprintf(stderr, "cooperative launch failed: %s (grid %d)\n", hipGetErrorString(e), grid_blocks);
}
```

```cpp
#include <hip/hip_runtime.h>
#include <hip/hip_cooperative_groups.h>
#include <cstdio>
#include <cstdint>
namespace cg = cooperative_groups;

#define LAS __attribute__((address_space(3)))
#define PG8_LAS LAS
#define DI __device__ __forceinline__
typedef unsigned short bf16_t;
typedef short bf16x8 __attribute__((ext_vector_type(8)));
typedef short s16x4 __attribute__((ext_vector_type(4)));
typedef float f32x2 __attribute__((ext_vector_type(2)));
typedef float f32x4 __attribute__((ext_vector_type(4)));
typedef float f32x16 __attribute__((ext_vector_type(16)));
typedef unsigned u32x2 __attribute__((ext_vector_type(2)));
typedef unsigned u32x4 __attribute__((ext_vector_type(4)));
typedef __bf16 bf16x2v __attribute__((ext_vector_type(2)));

DI int otid() { int t = threadIdx.x; asm volatile("" : "+v"(t)); return t; }
DI unsigned cvt2(float a, float b) { f32x2 v = {a, b}; bf16x2v r = __builtin_convertvector(v, bf16x2v); return __builtin_bit_cast(unsigned, r); }
DI float bf_lo(unsigned u) { return __uint_as_float(u << 16); }
DI float bf_hi(unsigned u) { return __uint_as_float(u & 0xffff0000u); }
DI float silu_f(float x) { return x / (1.0f + __expf(-x)); }
DI float sigmoid_f(float x) { return 1.0f / (1.0f + __expf(-x)); }

constexpr int SEQ = 4096, NTOK = 8192, DM = 2048, N0 = 7936, N1 = 8192, EV_IN = 7704;
constexpr int NB0 = 62, NB1 = 64;
#define HBLK(H, nblk, b, blk) ((H) + ((size_t)((b) * (nblk) + (blk)) * SEQ) * 128)
constexpr size_t MiB = 1u << 20;
constexpr size_t OFF_A = 0, OFF_B = 32 * MiB, OFF_BTO0 = 64 * MiB, OFF_BTO1 = 72 * MiB, OFF_D = 80 * MiB;
constexpr size_t OFF_W1KT = OFF_D, OFF_W1VT = OFF_D + MiB, OFF_COS = OFF_D + 2 * MiB, OFF_SIN = OFF_D + 3 * MiB;
constexpr size_t OFF_W2KT = OFF_D + 4 * MiB, OFF_W2VT = OFF_W2KT + 32768, OFF_KCMP = OFF_W2VT + 32768, OFF_VCMP = OFF_KCMP + 262144;
constexpr size_t OFF_SSQ = OFF_VCMP + 262144, OFF_CNT = OFF_SSQ + 524288;
constexpr size_t OFF_BAR = OFF_CNT + 256;
constexpr size_t OFF_E = 86 * MiB, OFF_QRAW = OFF_E + 126 * MiB, WS_NEED = OFF_E + 142 * MiB;
constexpr float ALPHA = 1.41421356237309515f;
constexpr float LAMBDA_INIT = 0.35550906759f;
constexpr float QK_C = 0.08838834764831845f * 1.4426950408889634f;

#ifndef REP_GEMM
#define REP_GEMM 1
#endif
#ifndef REP_P0
#define REP_P0 1
#endif
#ifndef REP_P2
#define REP_P2 1
#endif
#ifndef REP_LN
#define REP_LN 1
#endif
#ifndef REP_SYNC
#define REP_SYNC 0
#endif
#ifndef REP_P3
#define REP_P3 1
#endif
#ifndef REP_P7
#define REP_P7 1
#endif
struct Params {
  const float *x, *ev_w_in, *ev_pe_k, *ev_pe_v, *ev_w1_k, *ev_w2_k, *ev_w1_v, *ev_w2_v, *ev_w_out, *ev_ln_g, *ev_ln_b;
  const float *od_w_in, *od_lq1, *od_lk1, *od_lq2, *od_lk2, *od_gn_g, *od_w_out, *od_ln_g, *od_ln_b;
  float* out; char* ws;
};

namespace pg8 {
constexpr int BM = 256, BK = 64, HALF = 128, HTB = HALF * BK * 2, STAGE_BYTES = 8 * HTB, NXCD = 8, WGM = 8;
DI int lds_byte(int r, int c) { const int st = (r >> 4) * 2 + (c >> 5), rr = r & 15, cc = c & 31, ob = rr * 64 + cc * 2; return st * 1024 + (ob ^ (((ob >> 9) & 1) << 5)); }
DI void stage_rc(int b, int& R, int& C) { const int st = b / 1024, sb = b % 1024, swz = sb ^ (((sb >> 9) & 1) << 5); R = (st >> 1) * 16 + swz / 64; C = (st & 1) * 32 + (swz % 64) / 2; }
DI int perm32(int rho) { const int n = rho >> 4, i = rho & 15; return 8 * (i >> 2) + 4 * n + (i & 3); }
struct Unit { int pm, pn; };
struct Gemm { const bf16_t* A; const bf16_t* Bt; int M, N, K; };
struct StaticOrder {
    int nM, nN, nwg, G, c;
    DI void init(int M, int N, int G_, int c_) { nM = M / BM; nN = N / BM; nwg = nM * nN; G = G_; c = c_; }
    DI bool next(int i, Unit& u) const {
        const long L = (long)i * G + c; if (L >= nwg) return false;
        int wgid = (int)L; { const int q = nwg / NXCD, r = nwg % NXCD, xcd = wgid % NXCD, off = wgid / NXCD; wgid = (xcd < r ? xcd * (q + 1) : r * (q + 1) + (xcd - r) * q) + off; }
        const int nig = WGM * nN, gid = wgid / nig, fm = gid * WGM, gsz = (nM - fm) < WGM ? (nM - fm) : WGM;
        u.pm = fm + ((wgid % nig) % gsz); u.pn = (wgid % nig) / gsz; return true;
    }
    DI void a_ready(const Unit&) const {}
    DI void done(const Unit&) const {}
};
struct EpiH {
    static constexpr bool PERM = true, AFTER_DRAIN = false;
    bf16_t* H; int ldc; bf16_t* raw; int ldraw; const float* cosT; const float* sinT; unsigned rope_mask_lo; int rope_upto; int raw_upto;
    DI void operator()(const f32x4 (&acc)[2][2][4][2], const Unit& u, int wr, int wc, int fr, int fq) const {
        const int row0 = u.pm * BM + wr * 64 + fr, col0 = u.pn * BM + wc * 32 + 8 * fq;
        const bool rope = (u.pn < rope_upto) || ((rope_mask_lo >> u.pn) & 1u), wraw = u.pn < raw_upto;
#pragma unroll
        for (int ai = 0; ai < 2; ++ai)
#pragma unroll
            for (int m = 0; m < 4; ++m) { const int row = row0 + ai * HALF + m * 16; const int t = row & (SEQ - 1);
#pragma unroll
                for (int bj = 0; bj < 2; ++bj) { f32x4 v0 = acc[ai][bj][m][0], v1 = acc[ai][bj][m][1]; const int col = col0 + bj * HALF;
                    if (wraw) { u32x4 w; w.x = cvt2(v0[0], v0[1]); w.y = cvt2(v0[2], v0[3]); w.z = cvt2(v1[0], v1[1]); w.w = cvt2(v1[2], v1[3]); *(u32x4*)(raw + (size_t)row * ldraw + col) = w; }
                    if (rope) { const int i0 = (col & 127) >> 1; const f32x4 c = *(const f32x4*)(cosT + t * 64 + i0), s = *(const f32x4*)(sinT + t * 64 + i0);
                        f32x4 a0, a1;
                        a0[0] = v0[0] * c[0] - v0[1] * s[0]; a0[1] = v0[1] * c[0] + v0[0] * s[0]; a0[2] = v0[2] * c[1] - v0[3] * s[1]; a0[3] = v0[3] * c[1] + v0[2] * s[1];
                        a1[0] = v1[0] * c[2] - v1[1] * s[2]; a1[1] = v1[1] * c[2] + v1[0] * s[2]; a1[2] = v1[2] * c[3] - v1[3] * s[3]; a1[3] = v1[3] * c[3] + v1[2] * s[3];
                        v0 = a0; v1 = a1; }
                    u32x4 w; w.x = cvt2(v0[0], v0[1]); w.y = cvt2(v0[2], v0[3]); w.z = cvt2(v1[0], v1[1]); w.w = cvt2(v1[2], v1[3]);
                    *(u32x4*)(H + ((size_t)((row >> 12) * ldc + (col >> 7)) * SEQ + t) * 128 + (col & 127)) = w; } }
    }
};
struct EpiRes {
    static constexpr bool PERM = false, AFTER_DRAIN = false;
    float* R; const float* xres; int ldc;
    DI void operator()(const f32x4 (&acc)[2][2][4][2], const Unit& u, int wr, int wc, int fr, int fq) const {
        const int row0 = u.pm * BM + wr * 64 + fr, col0 = u.pn * BM + wc * 32 + 4 * fq;
#pragma unroll
        for (int ai = 0; ai < 2; ++ai)
#pragma unroll
            for (int m = 0; m < 4; ++m) { const size_t off = (size_t)(row0 + ai * HALF + m * 16) * ldc + col0;
#pragma unroll
                for (int bj = 0; bj < 2; ++bj)
#pragma unroll
                    for (int n = 0; n < 2; ++n) { const f32x4 xr = *(const f32x4*)(xres + off + bj * HALF + n * 16); *(f32x4*)(R + off + bj * HALF + n * 16) = acc[ai][bj][m][n] + xr * ALPHA; } }
    }
};
struct EpiRes1 {
    static constexpr bool PERM = false, AFTER_DRAIN = false;
    float* R; const float* R0; const float* stat; const float* g; const float* b; int ldc;
    DI void operator()(const f32x4 (&acc)[2][2][4][2], const Unit& u, int wr, int wc, int fr, int fq) const {
        const int row0 = u.pm * BM + wr * 64 + fr, col0 = u.pn * BM + wc * 32 + 4 * fq;
        f32x4 gv[2][2], bv[2][2];
#pragma unroll
        for (int bj = 0; bj < 2; ++bj)
#pragma unroll
            for (int n = 0; n < 2; ++n) { gv[bj][n] = *(const f32x4*)(g + col0 + bj * HALF + n * 16); bv[bj][n] = *(const f32x4*)(b + col0 + bj * HALF + n * 16); }
#pragma unroll
        for (int ai = 0; ai < 2; ++ai)
#pragma unroll
            for (int m = 0; m < 4; ++m) { const int row = row0 + ai * HALF + m * 16; const size_t off = (size_t)row * ldc + col0;
                const f32x2 ms = *(const f32x2*)(stat + 2 * row);
#pragma unroll
                for (int bj = 0; bj < 2; ++bj)
#pragma unroll
                    for (int n = 0; n < 2; ++n) { const f32x4 xr = *(const f32x4*)(R0 + off + bj * HALF + n * 16);
                        const f32x4 x1 = (xr - ms[0]) * ms[1] * gv[bj][n] + bv[bj][n]; *(f32x4*)(R + off + bj * HALF + n * 16) = acc[ai][bj][m][n] + x1 * ALPHA; } }
    }
};
template <class Epi, class Sched>
__device__ __forceinline__ void gemm_phase(PG8_LAS unsigned char* lds, const Gemm g, const Sched& S, const Epi& E) {
    const int tid = otid(), wid = __builtin_amdgcn_readfirstlane(tid >> 6), lane = tid & 63, wr = wid >> 2, wc = wid & 3, fr = lane & 15, fq = lane >> 4;
    const int K = g.K, nt = K / BK;
    unsigned voffA[2], voffB[2];
#pragma unroll
    for (int i = 0; i < 2; ++i) { int R, C; stage_rc(tid * 16 + i * 8192, R, C); const int Rb = Epi::PERM ? ((R & ~31) + perm32(R & 31)) : R;
        voffA[i] = (unsigned)(R * K + C) * 2u; voffB[i] = (unsigned)(Rb * K + C) * 2u; }
    const size_t kstep = (size_t)(BK * 2);
    const size_t hstep = (size_t)HALF * K * 2;
    const size_t tstep = 2 * hstep;
    const unsigned ldsw = (unsigned)wid * 1024u;
    const int aoff = lds_byte(wr * 64 + fr, fq * 8), boff = lds_byte(wc * 32 + fr, fq * 8);
#define PG8_SA(b, h) (((b) * 2 + (h)) * HTB)
#define PG8_SB(b, h) ((4 + (b) * 2 + (h)) * HTB)
#define PG8_STAGE(bufoff, gbase, voff) do { _Pragma("unroll") for (int _i = 0; _i < 2; ++_i) \
        __builtin_amdgcn_global_load_lds((const unsigned*)((const char*)(gbase) + (voff)[_i]), (PG8_LAS unsigned*)(lds + (bufoff) + ldsw + _i * 8192), 16, 0, 0); } while (0)
#define PG8_LDA(dst, b, h) do { _Pragma("unroll") for (int m = 0; m < 4; ++m) _Pragma("unroll") for (int k = 0; k < 2; ++k) dst[m][k] = *(const PG8_LAS bf16x8*)(lds + PG8_SA(b, h) + aoff + m * 2048 + k * 1024); } while (0)
#define PG8_LDB(dst, b, h) do { _Pragma("unroll") for (int n = 0; n < 2; ++n) _Pragma("unroll") for (int k = 0; k < 2; ++k) dst[n][k] = *(const PG8_LAS bf16x8*)(lds + PG8_SB(b, h) + boff + n * 2048 + k * 1024); } while (0)
#define PG8_MMA(ai, bj, At, Bt) do { __builtin_amdgcn_s_setprio(1); _Pragma("unroll") for (int m = 0; m < 4; ++m) _Pragma("unroll") for (int n = 0; n < 2; ++n) _Pragma("unroll") for (int k = 0; k < 2; ++k) \
        acc[ai][bj][m][n] = __builtin_amdgcn_mfma_f32_16x16x32_bf16(Bt[n][k], At[m][k], acc[ai][bj][m][n], 0, 0, 0); __builtin_amdgcn_s_setprio(0); } while (0)
#define PG8_WAIT_V(n) asm volatile("s_waitcnt vmcnt(" #n ")" ::: "memory")
#define PG8_WAIT_L(n) asm volatile("s_waitcnt lgkmcnt(" #n ")" ::: "memory")
#define PG8_BAR __builtin_amdgcn_s_barrier()
#define PG8_SCHED __builtin_amdgcn_sched_barrier(0)
    Unit cur, nxt; int ui = 0;
    if (!S.next(0, cur)) return;
    f32x4 acc[2][2][4][2];
#pragma unroll
    for (int a = 0; a < 2; ++a)
#pragma unroll
        for (int b = 0; b < 2; ++b)
#pragma unroll
            for (int m = 0; m < 4; ++m)
#pragma unroll
                for (int n = 0; n < 2; ++n) acc[a][b][m][n] = (f32x4){0.f, 0.f, 0.f, 0.f};
    bf16x8 At[4][2], B0[2][2], B1[2][2];
    const char* cA = (const char*)g.A + (size_t)cur.pm * tstep; const char* cB = (const char*)g.Bt + (size_t)cur.pn * tstep;
    S.a_ready(cur);
    PG8_STAGE(PG8_SB(0, 0), cB, voffB); PG8_STAGE(PG8_SA(0, 0), cA, voffA); PG8_STAGE(PG8_SB(0, 1), cB + hstep, voffB); PG8_STAGE(PG8_SA(0, 1), cA + hstep, voffA);
    if (wr == 1) PG8_BAR;
    PG8_WAIT_V(4); PG8_BAR;
    PG8_STAGE(PG8_SB(1, 0), cB + kstep, voffB); PG8_STAGE(PG8_SA(1, 0), cA + kstep, voffA); PG8_STAGE(PG8_SB(1, 1), cB + hstep + kstep, voffB);
    PG8_WAIT_V(6); PG8_BAR;
    for (;;) {
        const bool has_next = S.next(ui + 1, nxt);
        const char* nA = has_next ? (const char*)g.A + (size_t)nxt.pm * tstep : cA; const char* nB = has_next ? (const char*)g.Bt + (size_t)nxt.pn * tstep : cB;
        for (int t = 0; t < nt; t += 2) {
            const bool last = (t == nt - 2);
            const char* a1 = cA + (size_t)(t + 1) * kstep;
            const char* a2 = last ? nA : cA + (size_t)(t + 2) * kstep; const char* b2 = last ? nB : cB + (size_t)(t + 2) * kstep;
            const char* a3 = a2 + kstep; const char* b3 = b2 + kstep;
            if (last && has_next) S.a_ready(nxt);
            PG8_LDB(B0, 0, 0); PG8_SCHED; PG8_LDA(At, 0, 0); PG8_STAGE(PG8_SA(1, 1), a1 + hstep, voffA);
            PG8_WAIT_L(8); PG8_BAR; PG8_WAIT_L(0); PG8_MMA(0, 0, At, B0); PG8_BAR; PG8_SCHED;
            PG8_LDB(B1, 0, 1); PG8_STAGE(PG8_SB(0, 0), b2, voffB);
            PG8_BAR; PG8_WAIT_L(0); PG8_MMA(0, 1, At, B1); PG8_BAR;
            PG8_LDA(At, 0, 1); PG8_STAGE(PG8_SA(0, 0), a2, voffA);
            PG8_BAR; PG8_WAIT_L(0); PG8_MMA(1, 0, At, B0); PG8_BAR; PG8_SCHED;
            PG8_STAGE(PG8_SB(0, 1), b2 + hstep, voffB);
            PG8_WAIT_V(6); PG8_BAR; PG8_MMA(1, 1, At, B1); PG8_BAR;
            PG8_LDB(B0, 1, 0); PG8_SCHED; PG8_LDA(At, 1, 0); PG8_STAGE(PG8_SA(0, 1), a2 + hstep, voffA);
            PG8_WAIT_L(8); PG8_BAR; PG8_WAIT_L(0); PG8_MMA(0, 0, At, B0); PG8_BAR; PG8_SCHED;
            PG8_LDB(B1, 1, 1); PG8_STAGE(PG8_SB(1, 0), b3, voffB);
            PG8_BAR; PG8_WAIT_L(0); PG8_MMA(0, 1, At, B1); PG8_BAR;
            PG8_LDA(At, 1, 1); PG8_STAGE(PG8_SA(1, 0), a3, voffA);
            PG8_BAR; PG8_WAIT_L(0); PG8_MMA(1, 0, At, B0); PG8_BAR; PG8_SCHED;
            PG8_STAGE(PG8_SB(1, 1), b3 + hstep, voffB);
            PG8_WAIT_V(6); PG8_BAR; PG8_MMA(1, 1, At, B1); PG8_BAR;
        }
        if constexpr (!Epi::AFTER_DRAIN) { E(acc, cur, wr, wc, fr, fq); S.done(cur); }
        if (!has_next) break;
#pragma unroll
        for (int a = 0; a < 2; ++a)
#pragma unroll
            for (int b = 0; b < 2; ++b)
#pragma unroll
                for (int m = 0; m < 4; ++m)
#pragma unroll
                    for (int n = 0; n < 2; ++n) acc[a][b][m][n] = (f32x4){0.f, 0.f, 0.f, 0.f};
        cur = nxt; cA = nA; cB = nB; ++ui;
    }
    PG8_WAIT_V(0);
    if (wr == 0) PG8_BAR;
    PG8_BAR;
    if constexpr (Epi::AFTER_DRAIN) { E.fused(acc, cur, wr, wc, fr, fq, lds, wid, lane); S.done(cur); }
#undef PG8_SA
#undef PG8_SB
#undef PG8_STAGE
#undef PG8_LDA
#undef PG8_LDB
#undef PG8_MMA
#undef PG8_WAIT_V
#undef PG8_WAIT_L
#undef PG8_BAR
#undef PG8_SCHED
}
}

DI int rope_perm(int n) { const int d = n & 127; return (n & ~127) + (d >> 1) + 64 * (d & 1); }
DI int colmap(int mode, int n) {
  if (mode == 0) return n;
  if (mode == 1) {
    if (n < 2560) { const bool rp = (n < 1024) || (n >= 1536 && n < 1792) || (n >= 2048 && n < 2304); return rp ? rope_perm(n) : n; }
    if (n < 7680) return n + 24;
    if (n < 7704) return n - 7680 + 2560;
    return -1; }
  if (mode == 2) return n < 4096 ? rope_perm(n) : n;
  return rope_perm(n);
}
DI void transpose_tile(const float* __restrict__ W, int ldw, int K, int mode, bf16_t* __restrict__ Bt, int n0, int k0, LAS float* tl  ) {
  const int tid = otid();
  int srcbase = n0, nvalid = 128; bool perm = false;
  if (mode == 1) { perm = (n0 < 1024) || n0 == 1536 || n0 == 1664 || n0 == 2048 || n0 == 2176;
    if (n0 >= 2560) { if (n0 < 7680) srcbase = n0 + 24; else if (n0 == 7680) { srcbase = 2560; nvalid = 24; } else { srcbase = 0; nvalid = 0; } } }
  else if (mode == 2) perm = n0 < 4096;
  else if (mode == 3) perm = true;
  const int c4 = tid & 31, kq = tid >> 5;
  f32x4 v[8];
#pragma unroll
  for (int j = 0; j < 8; ++j) { const int kk = kq + 16 * j;
    if (4 * c4 < nvalid) v[j] = *(const f32x4*)(W + (size_t)(k0 + kk) * ldw + srcbase + 4 * c4); else v[j] = (f32x4){0.f, 0.f, 0.f, 0.f}; }
#pragma unroll
  for (int j = 0; j < 8; ++j) { const int kk = kq + 16 * j;
#pragma unroll
    for (int e = 0; e < 4; ++e) { const int sj = 4 * c4 + e; const int dl = perm ? ((sj < 64) ? 2 * sj : 2 * (sj - 64) + 1) : sj; tl[dl * 129 + kk] = v[j][e]; } }
  __syncthreads();
  const int n2 = tid >> 2, kc = (tid & 3) * 32; const LAS float* r = tl + n2 * 129 + kc;
#pragma unroll
  for (int u = 0; u < 4; ++u) { u32x4 w; w.x = cvt2(r[8 * u], r[8 * u + 1]); w.y = cvt2(r[8 * u + 2], r[8 * u + 3]); w.z = cvt2(r[8 * u + 4], r[8 * u + 5]); w.w = cvt2(r[8 * u + 6], r[8 * u + 7]);
    *(u32x4*)(Bt + (size_t)(n0 + n2) * K + k0 + kc + 8 * u) = w; }
  __syncthreads();
}
DI void tr_matrix(const float* W, int ldw, int K, int N, int mode, bf16_t* Bt, int& base, int bid, int nb, LAS float* tl) {
  const int nk = K / 128, ntile = (N / 128) * nk;
  const int first = (((bid - base) % nb) + nb) % nb;
  for (int i = first; i < ntile; i += nb) { const int nt = i / nk, kt = i - nt * nk; transpose_tile(W, ldw, K, mode, Bt, nt * 128, kt * 128, tl); }
  base += ntile;
}

DI float wave_sum(float v) {
#pragma unroll
  for (int o = 32; o > 0; o >>= 1) v += __shfl_xor(v, o, 64);
  return v;
}
DI void ln_phase(const float* __restrict__ R, const float* __restrict__ g, const float* __restrict__ bta, float* __restrict__ outf, bf16_t* __restrict__ outb, float* __restrict__ stat) {
  const int tid = otid(), w = tid >> 6, lane = tid & 63;
  f32x4 gv[8], bv[8];
#pragma unroll
  for (int i = 0; i < 8; ++i) { gv[i] = ((const f32x4*)g)[lane + 64 * i]; bv[i] = ((const f32x4*)bta)[lane + 64 * i]; }
  for (int row = blockIdx.x * 8 + w; row < NTOK; row += gridDim.x * 8) {
    const f32x4* rp = (const f32x4*)(R + (size_t)row * DM); f32x4 v[8]; float s = 0.f;
#pragma unroll
    for (int i = 0; i < 8; ++i) { v[i] = rp[lane + 64 * i]; s += (v[i][0] + v[i][1]) + (v[i][2] + v[i][3]); }
    const float mu = wave_sum(s) * (1.0f / DM); float q = 0.f;
#pragma unroll
    for (int i = 0; i < 8; ++i) { v[i] = v[i] - mu; q += (v[i][0] * v[i][0] + v[i][1] * v[i][1]) + (v[i][2] * v[i][2] + v[i][3] * v[i][3]); }
    const float rstd = __builtin_amdgcn_rsqf(wave_sum(q) * (1.0f / DM) + 1e-5f);
    if (stat && lane == 0) { f32x2 ms = {mu, rstd}; *(f32x2*)(stat + 2 * row) = ms; }
#pragma unroll
    for (int i = 0; i < 8; ++i) { const f32x4 y = v[i] * rstd * gv[i] + bv[i]; if (outf) ((f32x4*)(outf + (size_t)row * DM))[lane + 64 * i] = y;
      if (outb) { u32x2 w2; w2.x = cvt2(y[0], y[1]); w2.y = cvt2(y[2], y[3]); ((u32x2*)(outb + (size_t)row * DM))[lane + 64 * i] = w2; } }
  }
}

#define MFMA32(a, b, c) __builtin_amdgcn_mfma_f32_32x32x16_bf16((a), (b), (c), 0, 0, 0)
DI void compress_block(const Params& p, int cb, LAS char* lds) {
  const int tid = otid(), w = __builtin_amdgcn_readfirstlane(tid >> 6), lane = tid & 63, r32 = lane & 31, hi = lane >> 5;
  const int tensor = cb >> 5, m0 = (cb & 31) * 32, kq = w;
  const bf16_t* H0 = (const bf16_t*)(p.ws + OFF_E);
  const bf16_t* W1T = (const bf16_t*)(p.ws + (tensor ? OFF_W1VT : OFF_W1KT));
  const bf16_t* W2T = (const bf16_t*)(p.ws + (tensor ? OFF_W2VT : OFF_W2KT));
  const float* pe = tensor ? p.ev_pe_v : p.ev_pe_k;
  bf16_t* outp = (bf16_t*)(p.ws + (tensor ? OFF_VCMP : OFF_KCMP));
  const int m = m0 + r32, bh = m >> 8, b = bh >> 1, hk = bh & 1, n = m & 255;
  const int colblk = (tensor ? 10 : 8) + hk;
  const bf16_t* w1r = W1T + (size_t)r32 * 4096 + 8 * hi;
  f32x16 acc[4];
#pragma unroll
  for (int j = 0; j < 4; ++j) for (int i = 0; i < 16; ++i) acc[j][i] = 0.f;
  for (int l = 4 * kq; l < 4 * kq + 4; ++l) {
    int tok = 16 * n + l; tok = tok > SEQ - 1 ? SEQ - 1 : tok;
    const bf16_t* src = HBLK(H0, NB0, b, colblk) + (size_t)tok * 128 + 8 * hi;
    const float* pel = pe + l * 128 + 8 * hi;
#pragma unroll
    for (int s8 = 0; s8 < 8; ++s8) {
      const u32x4 hv = *(const u32x4*)(src + 16 * s8);
      const f32x4 pa = *(const f32x4*)(pel + 16 * s8), pb = *(const f32x4*)(pel + 16 * s8 + 4);
      u32x4 fv; fv.x = cvt2(bf_lo(hv.x) + pa[0], bf_hi(hv.x) + pa[1]); fv.y = cvt2(bf_lo(hv.y) + pa[2], bf_hi(hv.y) + pa[3]);
      fv.z = cvt2(bf_lo(hv.z) + pb[0], bf_hi(hv.z) + pb[1]); fv.w = cvt2(bf_lo(hv.w) + pb[2], bf_hi(hv.w) + pb[3]);
      const bf16x8 bfrag = __builtin_bit_cast(bf16x8, fv);
#pragma unroll
      for (int j = 0; j < 4; ++j) { const bf16x8 af = *(const bf16x8*)(w1r + (size_t)(32 * j) * 4096 + l * 128 + 16 * s8); acc[j] = MFMA32(af, bfrag, acc[j]); }
    }
  }
  LAS bf16_t* hid = (LAS bf16_t*)lds;
  LAS float* red = (LAS float*)(lds + 16384);
  {
    const int slot = kq > 0 ? kq - 1 : 7;
#pragma unroll
    for (int j = 0; j < 4; ++j) { LAS float* r0 = red + ((slot * 4 + j) * 64 + lane) * 16;
#pragma unroll
      for (int q4 = 0; q4 < 4; ++q4) { f32x4 v0 = {acc[j][4 * q4], acc[j][4 * q4 + 1], acc[j][4 * q4 + 2], acc[j][4 * q4 + 3]}; *(LAS f32x4*)(r0 + 4 * q4) = v0; } }
  }
  __syncthreads();
  if (w < 4) { const int j = w;
#pragma unroll
    for (int q4 = 0; q4 < 4; ++q4) { f32x4 s0 = {0.f, 0.f, 0.f, 0.f};
#pragma unroll
      for (int k = 0; k < 7; ++k) { const LAS float* r0 = red + ((k * 4 + j) * 64 + lane) * 16; s0 = s0 + *(const LAS f32x4*)(r0 + 4 * q4); }
      const LAS float* rz = red + ((7 * 4 + j) * 64 + lane) * 16; s0 = s0 + *(const LAS f32x4*)(rz + 4 * q4);
      const int col = 32 * j + 8 * q4 + 4 * hi;
      u32x2 v; v.x = cvt2(silu_f(s0[0]), silu_f(s0[1])); v.y = cvt2(silu_f(s0[2]), silu_f(s0[3])); *(LAS u32x2*)(hid + r32 * 136 + col) = v; }
  }
  __syncthreads();
  if (w < 4) { const int ct = w;
    f32x16 acc2; for (int i = 0; i < 16; ++i) acc2[i] = 0.f;
#pragma unroll
    for (int s = 0; s < 8; ++s) { const bf16x8 afrag = *(const bf16x8*)(W2T + (32 * ct + r32) * 128 + 16 * s + 8 * hi);
      const bf16x8 bfrag = *(LAS bf16x8*)(hid + r32 * 136 + 16 * s + 8 * hi); acc2 = MFMA32(afrag, bfrag, acc2); }
#pragma unroll
    for (int q4 = 0; q4 < 4; ++q4) { const int col = 32 * ct + 8 * q4 + 4 * hi; u32x2 v; v.x = cvt2(acc2[4 * q4], acc2[4 * q4 + 1]); v.y = cvt2(acc2[4 * q4 + 2], acc2[4 * q4 + 3]);
      *(u32x2*)(outp + (size_t)m * 128 + col) = v; }
  }
  __syncthreads();
}

constexpr int KBUF = 16384, VROW = 320, VBUF = 64 * VROW;
constexpr int LDS_K0 = 0, LDS_V0 = 2 * KBUF, LDS_MISC = LDS_V0 + 2 * VBUF;
constexpr int LDS_IMP = LDS_MISC + 256, LDS_MASK = LDS_IMP + 64 * 65 * 4, LDS_Q = LDS_MASK + 512, LDS_ATT_END = LDS_Q + 65536, LDS_XB = LDS_ATT_END;
#define KSWZ(row, colB) ((row) * 256 + ((colB) ^ (((((row) & 7) | ((((row) >> 4) & 1) << 3))) << 4)))
DI int crow(int r, int hi) { return (r & 3) + 8 * (r >> 2) + 4 * hi; }
struct Stage { bf16x8 k0, k1, v0, v1; };
DI void stage_load(int tid, Stage& s, const bf16_t* __restrict__ Kg, int ldk, const bf16_t* __restrict__ Vg, int ldv, int key0) {
  const int row = tid >> 4, d8 = (tid & 15) * 8;
  s.k0 = *(const bf16x8*)(Kg + (size_t)(key0 + row) * ldk + d8); s.k1 = *(const bf16x8*)(Kg + (size_t)(key0 + 32 + row) * ldk + d8);
  s.v0 = *(const bf16x8*)(Vg + (size_t)(key0 + row) * ldv + d8); s.v1 = *(const bf16x8*)(Vg + (size_t)(key0 + 32 + row) * ldv + d8);
}
DI void stage_write(int tid, const Stage& s, LAS char* lds, int buf) {
  const int row = tid >> 4, cb = (tid & 15) * 16;
  *(LAS bf16x8*)(lds + LDS_K0 + buf * KBUF + KSWZ(row, cb)) = s.k0; *(LAS bf16x8*)(lds + LDS_K0 + buf * KBUF + KSWZ(row + 32, cb)) = s.k1;
  *(LAS bf16x8*)(lds + LDS_V0 + buf * VBUF + row * VROW + cb) = s.v0; *(LAS bf16x8*)(lds + LDS_V0 + buf * VBUF + (row + 32) * VROW + cb) = s.v1;
}
DI void load_q(LAS char* qs, const bf16_t* qrow  ) {
#pragma unroll
  for (int d0 = 0; d0 < 8; ++d0) *(LAS bf16x8*)(qs + 1024 * d0) = *(const bf16x8*)(qrow + 16 * d0);
}
DI void qkt(f32x16& p0, f32x16& p1, LAS char* Kb, LAS char* qs, int r32, int hi) {
  for (int i = 0; i < 16; ++i) { p0[i] = 0.f; p1[i] = 0.f; }
#pragma unroll
  for (int d0 = 0; d0 < 8; ++d0) { const int cb = (d0 * 16 + hi * 8) * 2;
    const bf16x8 a0 = *(LAS bf16x8*)(Kb + KSWZ(r32, cb)); const bf16x8 a1 = *(LAS bf16x8*)(Kb + KSWZ(32 + r32, cb));
    const bf16x8 qf = *(LAS bf16x8*)(qs + 1024 * d0);
    p0 = MFMA32(a0, qf, p0); p1 = MFMA32(a1, qf, p1); }
}
DI bf16x8 pack8(const f32x16& p, int base) {
  u32x4 w; w.x = cvt2(p[base], p[base + 1]); w.y = cvt2(p[base + 2], p[base + 3]); w.z = cvt2(p[base + 4], p[base + 5]); w.w = cvt2(p[base + 6], p[base + 7]);
  return __builtin_bit_cast(bf16x8, w);
}
DI void pv(f32x16 (&o)[4], LAS char* Vb, const f32x16& p0, const f32x16& p1, int lane) {
  bf16x8 pf[4]; pf[0] = pack8(p0, 0); pf[1] = pack8(p0, 8); pf[2] = pack8(p1, 0); pf[3] = pack8(p1, 8);
  const int hi = lane >> 5, i16 = lane & 15, q = i16 >> 2, pp = i16 & 3, blk = (lane >> 4) & 1;
  LAS char* vb = Vb + (4 * hi + q) * VROW + (16 * blk + 4 * pp) * 2;
#pragma unroll
  for (int db = 0; db < 4; ++db) {
    __builtin_amdgcn_sched_barrier(0);
#pragma unroll
    for (int s = 0; s < 4; ++s) {
      const s16x4 lo = __builtin_amdgcn_ds_read_tr16_b64_v4i16((LAS s16x4*)(vb + (16 * s) * VROW + 64 * db));
      const s16x4 hh = __builtin_amdgcn_ds_read_tr16_b64_v4i16((LAS s16x4*)(vb + (16 * s + 8) * VROW + 64 * db));
      const bf16x8 vf = __builtin_shufflevector(lo, hh, 0, 1, 2, 3, 4, 5, 6, 7);
      o[db] = MFMA32(vf, pf[s], o[db]);
    }
  }
  __builtin_amdgcn_sched_barrier(0);
}
DI float pair_max(float v) { const auto rr = __builtin_amdgcn_permlane32_swap(__float_as_uint(v), __float_as_uint(v), false, false); return fmaxf(__uint_as_float(rr[0]), __uint_as_float(rr[1])); }
DI float pair_sum(float v) { const auto rr = __builtin_amdgcn_permlane32_swap(__float_as_uint(v), __float_as_uint(v), false, false); return __uint_as_float(rr[0]) + __uint_as_float(rr[1]); }
DI void softmax_tile(f32x16& p0, f32x16& p1, int lo, int hh, bool lane_on, bool elem_mask, float& m_run, float& l_run, f32x16 (&o)[4], int hi) {
  const float NINF = -__builtin_inff();
  if (elem_mask) {
#pragma unroll
    for (int r = 0; r < 16; ++r) { const int kk = crow(r, hi); const bool v0 = kk >= lo && kk <= hh, v1 = (kk + 32) >= lo && (kk + 32) <= hh;
      p0[r] = v0 ? p0[r] : NINF; p1[r] = v1 ? p1[r] : NINF; }
  }
  float pm = fmaxf(p0[0], p1[0]);
#pragma unroll
  for (int r = 1; r < 16; ++r) pm = fmaxf(fmaxf(pm, p0[r]), p1[r]);
  pm = lane_on ? pm : NINF;
  pm = pair_max(pm) * QK_C;
  if (!__all(pm <= m_run + 8.0f)) {
    const float mn = fmaxf(m_run, pm), alpha = __builtin_amdgcn_exp2f(m_run - mn); m_run = mn; l_run *= alpha;
#pragma unroll
    for (int db = 0; db < 4; ++db)
#pragma unroll
      for (int r = 0; r < 16; ++r) o[db][r] *= alpha;
  }
  const float nm = lane_on ? -m_run : NINF;
  float ls = 0.f;
#pragma unroll
  for (int r = 0; r < 16; ++r) { p0[r] = __builtin_amdgcn_exp2f(fmaf(p0[r], QK_C, nm)); ls += p0[r]; }
#pragma unroll
  for (int r = 0; r < 16; ++r) { p1[r] = __builtin_amdgcn_exp2f(fmaf(p1[r], QK_C, nm)); ls += p1[r]; }
  l_run += ls;
}
#define WBAR() do { asm volatile("s_waitcnt lgkmcnt(0)" ::: "memory"); __builtin_amdgcn_s_barrier(); asm volatile("" ::: "memory"); } while (0)
#define FP_COMPUTE(J, BUF) do { \
    const int tile_ = tile0 + (J), key0_ = tile_ * 64; \
    const bool lsel_ = (sel >> tile_) & 1ull; const int lo_ = klo - key0_, hh_ = khi - key0_; \
    const bool on_ = lsel_ && hh_ >= 0 && lo_ <= 63, fullv_ = lo_ <= 0 && hh_ >= 63; \
    f32x16 p0, p1; \
    qkt(p0, p1, lds + LDS_K0 + (BUF) * KBUF, qs, r32, hi); \
    softmax_tile(p0, p1, lo_, hh_, on_, __any(on_ && !fullv_), m_run, l_run, o, hi); \
    pv(o, lds + LDS_V0 + (BUF) * VBUF, p0, p1, lane); \
  } while (0)
DI void flash_pass(int tid, const bf16_t* Kg, int ldk, const bf16_t* Vg, int ldv, int tile0, int ntiles, LAS char* qs,
                   int klo, int khi, unsigned long long sel, f32x16 (&o)[4], float& m_run, float& l_run, LAS char* lds) {
  const int lane = tid & 63, r32 = lane & 31, hi = lane >> 5;
  const int first = tile0 * 64, last = (tile0 + ntiles - 1) * 64;
  Stage sA, sB;
  stage_load(tid, sA, Kg, ldk, Vg, ldv, first); stage_write(tid, sA, lds, 0);
  { const int k = first + 64; stage_load(tid, sA, Kg, ldk, Vg, ldv, k < last ? k : last); }
  { const int k = first + 128; stage_load(tid, sB, Kg, ldk, Vg, ldv, k < last ? k : last); }
  WBAR();
  for (int it = 0; it < ntiles; it += 2) {
    FP_COMPUTE(it, 0);
    stage_write(tid, sA, lds, 1);
    { const int k = first + (it + 3) * 64; stage_load(tid, sA, Kg, ldk, Vg, ldv, k < last ? k : last); }
    WBAR();
    if (it + 1 < ntiles) FP_COMPUTE(it + 1, 1);
    stage_write(tid, sB, lds, 0);
    { const int k = first + (it + 4) * 64; stage_load(tid, sB, Kg, ldk, Vg, ldv, k < last ? k : last); }
    WBAR();
  }
  __syncthreads();
}
constexpr int K2BUF = 8192, V2ROW = 576, V2BUF = 32 * V2ROW, LDS2_K0 = 0, LDS2_V0 = 2 * K2BUF;
struct Stage2 { bf16x8 k0, v0, v1; };
DI void stage2_load(int tid, Stage2& s, const bf16_t* __restrict__ Kg, int ldk, const bf16_t* __restrict__ Vg, int ldv, int key0) {
  s.k0 = *(const bf16x8*)(Kg + (size_t)(key0 + (tid >> 4)) * ldk + (tid & 15) * 8);
  const bf16_t* vp = Vg + (size_t)((tid >> 4) & 1) * SEQ * 128 + (tid & 15) * 8;
  s.v0 = *(const bf16x8*)(vp + (size_t)(key0 + (tid >> 5)) * ldv);
  s.v1 = *(const bf16x8*)(vp + (size_t)(key0 + 16 + (tid >> 5)) * ldv);
}
DI void stage2_write(int tid, const Stage2& s, LAS char* lds, int buf) {
  *(LAS bf16x8*)(lds + LDS2_K0 + buf * K2BUF + KSWZ(tid >> 4, (tid & 15) * 16)) = s.k0;
  *(LAS bf16x8*)(lds + LDS2_V0 + buf * V2BUF + (tid >> 5) * V2ROW + (tid & 31) * 16) = s.v0;
  *(LAS bf16x8*)(lds + LDS2_V0 + buf * V2BUF + (16 + (tid >> 5)) * V2ROW + (tid & 31) * 16) = s.v1;
}
#define F256_COMPUTE(IT, BUF) do { \
    const int hh = t - (IT) * 32; \
    f32x16 p0; for (int i = 0; i < 16; ++i) p0[i] = 0.f; \
    LAS char* Kb = lds + LDS2_K0 + (BUF) * K2BUF; \
    _Pragma("unroll") for (int d0 = 0; d0 < 8; ++d0) { const int cb = (d0 * 16 + hi * 8) * 2; const bf16x8 a0 = *(LAS bf16x8*)(Kb + KSWZ(r32, cb)); const bf16x8 qf = *(LAS bf16x8*)(qs + 1024 * d0); p0 = MFMA32(a0, qf, p0); } \
    if (!__all(hh >= 31)) { _Pragma("unroll") for (int r = 0; r < 16; ++r) p0[r] = crow(r, hi) <= hh ? p0[r] : NINF; } \
    float pm = p0[0]; \
    _Pragma("unroll") for (int r = 1; r < 16; ++r) pm = fmaxf(pm, p0[r]); \
    pm = pair_max(pm) * QK_C; \
    if (!__all(pm <= m_run + 8.0f)) { \
      const float mn = fmaxf(m_run, pm), alpha = __builtin_amdgcn_exp2f(m_run - mn); m_run = mn; l_run *= alpha; \
      _Pragma("unroll") for (int db = 0; db < 8; ++db) _Pragma("unroll") for (int r = 0; r < 16; ++r) o[db][r] *= alpha; } \
    const float nm = -m_run; float ls = 0.f; \
    _Pragma("unroll") for (int r = 0; r < 16; ++r) { p0[r] = __builtin_amdgcn_exp2f(fmaf(p0[r], QK_C, nm)); ls += p0[r]; } \
    l_run += ls; \
    bf16x8 pf[2]; pf[0] = pack8(p0, 0); pf[1] = pack8(p0, 8); \
    LAS char* vb = lds + LDS2_V0 + (BUF) * V2BUF + (4 * hi + q) * V2ROW + (16 * blk + 4 * pp) * 2; \
    _Pragma("unroll") for (int db = 0; db < 8; ++db) { \
      __builtin_amdgcn_sched_barrier(0); \
      _Pragma("unroll") for (int s2 = 0; s2 < 2; ++s2) { \
        const s16x4 lo = __builtin_amdgcn_ds_read_tr16_b64_v4i16((LAS s16x4*)(vb + (16 * s2) * V2ROW + 64 * db)); \
        const s16x4 h2 = __builtin_amdgcn_ds_read_tr16_b64_v4i16((LAS s16x4*)(vb + (16 * s2 + 8) * V2ROW + 64 * db)); \
        const bf16x8 vf = __builtin_shufflevector(lo, h2, 0, 1, 2, 3, 4, 5, 6, 7); \
        o[db] = MFMA32(vf, pf[s2], o[db]); } } \
    __builtin_amdgcn_sched_barrier(0); \
  } while (0)
DI void flash256_pass(int tid, const bf16_t* Kg, int ldk, const bf16_t* Vg, int ldv, int ntiles, LAS char* qs, int t, f32x16 (&o)[8], float& m_run, float& l_run, LAS char* lds) {
  const int lane = tid & 63, r32 = lane & 31, hi = lane >> 5;
  const int i16 = lane & 15, q = i16 >> 2, pp = i16 & 3, blk = (lane >> 4) & 1;
  const float NINF = -__builtin_inff();
  Stage2 sA, sB;
  const int last = (ntiles - 1) * 32;
  stage2_load(tid, sA, Kg, ldk, Vg, ldv, 0); stage2_write(tid, sA, lds, 0);
  stage2_load(tid, sA, Kg, ldk, Vg, ldv, 32);
  stage2_load(tid, sB, Kg, ldk, Vg, ldv, 64);
  WBAR();
  for (int it = 0; it < ntiles; it += 2) {
    F256_COMPUTE(it, 0);
    stage2_write(tid, sA, lds, 1);
    { const int k = (it + 3) * 32; stage2_load(tid, sA, Kg, ldk, Vg, ldv, k < last ? k : last); }
    WBAR();
    F256_COMPUTE(it + 1, 1);
    stage2_write(tid, sB, lds, 0);
    { const int k = (it + 4) * 32; stage2_load(tid, sB, Kg, ldk, Vg, ldv, k < last ? k : last); }
    WBAR();
  }
  __syncthreads();
}
#define F256C_COMPUTE(IT, BUF) do { \
    const int hh = t - (IT) * 32; \
    f32x16 p0; for (int i = 0; i < 16; ++i) p0[i] = 0.f; \
    LAS char* Kb = lds + ((BUF) * 2 + grp) * K2BUF; \
    _Pragma("unroll") for (int d0 = 0; d0 < 8; ++d0) { const int cb = (d0 * 16 + hi * 8) * 2; const bf16x8 a0 = *(LAS bf16x8*)(Kb + KSWZ(r32, cb)); const bf16x8 qf = *(LAS bf16x8*)(qs + 1024 * d0); p0 = MFMA32(a0, qf, p0); } \
    if (!__all(hh >= 31)) { _Pragma("unroll") for (int r = 0; r < 16; ++r) p0[r] = crow(r, hi) <= hh ? p0[r] : NINF; } \
    float pm = p0[0]; \
    _Pragma("unroll") for (int r = 1; r < 16; ++r) pm = fmaxf(pm, p0[r]); \
    pm = pair_max(pm) * QK_C; \
    if (!__all(pm <= m_run + 8.0f)) { \
      const float mn = fmaxf(m_run, pm), alpha = __builtin_amdgcn_exp2f(m_run - mn); m_run = mn; l_run *= alpha; \
      _Pragma("unroll") for (int db = 0; db < 8; ++db) _Pragma("unroll") for (int r = 0; r < 16; ++r) o[db][r] *= alpha; } \
    const float nm = -m_run; float ls = 0.f; \
    _Pragma("unroll") for (int r = 0; r < 16; ++r) { p0[r] = __builtin_amdgcn_exp2f(fmaf(p0[r], QK_C, nm)); ls += p0[r]; } \
    l_run += ls; \
    bf16x8 pf[2]; pf[0] = pack8(p0, 0); pf[1] = pack8(p0, 8); \
    LAS char* vb = lds + LDS3_V0 + (BUF) * V2BUF + (4 * hi + q) * V2ROW + (16 * blk + 4 * pp) * 2; \
    _Pragma("unroll") for (int db = 0; db < 8; ++db) { \
      __builtin_amdgcn_sched_barrier(0); \
      _Pragma("unroll") for (int s2 = 0; s2 < 2; ++s2) { \
        const s16x4 lo = __builtin_amdgcn_ds_read_tr16_b64_v4i16((LAS s16x4*)(vb + (16 * s2) * V2ROW + 64 * db)); \
        const s16x4 h2 = __builtin_amdgcn_ds_read_tr16_b64_v4i16((LAS s16x4*)(vb + (16 * s2 + 8) * V2ROW + 64 * db)); \
        const bf16x8 vf = __builtin_shufflevector(lo, h2, 0, 1, 2, 3, 4, 5, 6, 7); \
        o[db] = MFMA32(vf, pf[s2], o[db]); } } \
    __builtin_amdgcn_sched_barrier(0); \
  } while (0)
constexpr int LDS3_V0 = 4 * K2BUF;
struct Stage3 { bf16x8 k0, k1, v0, v1; };
DI void stage3_load(int tid, Stage3& s, const bf16_t* __restrict__ K0g, const bf16_t* __restrict__ K1g, const bf16_t* __restrict__ Vg, int key0) {
  const size_t ko = (size_t)(key0 + (tid >> 4)) * 128 + (tid & 15) * 8;
  s.k0 = *(const bf16x8*)(K0g + ko); s.k1 = *(const bf16x8*)(K1g + ko);
  const bf16_t* vp = Vg + (size_t)((tid >> 4) & 1) * SEQ * 128 + (tid & 15) * 8;
  s.v0 = *(const bf16x8*)(vp + (size_t)(key0 + (tid >> 5)) * 128); s.v1 = *(const bf16x8*)(vp + (size_t)(key0 + 16 + (tid >> 5)) * 128);
}
DI void stage3_write(int tid, const Stage3& s, LAS char* lds, int buf) {
  *(LAS bf16x8*)(lds + (buf * 2 + 0) * K2BUF + KSWZ(tid >> 4, (tid & 15) * 16)) = s.k0;
  *(LAS bf16x8*)(lds + (buf * 2 + 1) * K2BUF + KSWZ(tid >> 4, (tid & 15) * 16)) = s.k1;
  *(LAS bf16x8*)(lds + LDS3_V0 + buf * V2BUF + (tid >> 5) * V2ROW + (tid & 31) * 16) = s.v0;
  *(LAS bf16x8*)(lds + LDS3_V0 + buf * V2BUF + (16 + (tid >> 5)) * V2ROW + (tid & 31) * 16) = s.v1;
}
DI void flash256c_pass(int tid, const bf16_t* K0g, const bf16_t* K1g, const bf16_t* Vg, int ntiles, LAS char* qs, int t, f32x16 (&o)[8], float& m_run, float& l_run, LAS char* lds) {
  const int lane = tid & 63, r32 = lane & 31, hi = lane >> 5;
  const int i16 = lane & 15, q = i16 >> 2, pp = i16 & 3, blk = (lane >> 4) & 1;
  const int grp = __builtin_amdgcn_readfirstlane(tid >> 8);
  const float NINF = -__builtin_inff();
  Stage3 st;
  const int last = (ntiles - 1) * 32;
  stage3_load(tid, st, K0g, K1g, Vg, 0); stage3_write(tid, st, lds, 0);
  stage3_load(tid, st, K0g, K1g, Vg, 32);
  WBAR();
  for (int it = 0; it < ntiles; it += 2) {
    F256C_COMPUTE(it, 0);
    stage3_write(tid, st, lds, 1);
    { const int k = (it + 2) * 32; stage3_load(tid, st, K0g, K1g, Vg, k < last ? k : last); }
    WBAR();
    F256C_COMPUTE(it + 1, 1);
    stage3_write(tid, st, lds, 0);
    { const int k = (it + 3) * 32; stage3_load(tid, st, K0g, K1g, Vg, k < last ? k : last); }
    WBAR();
  }
  __syncthreads();
}
#define LADD(ptr, v) __hip_atomic_fetch_add((ptr), (v), __ATOMIC_RELAXED, __HIP_MEMORY_SCOPE_WORKGROUP)
DI void cmp_importance(int tid, const bf16_t* Kg, int ntiles, LAS char* qs, int khi, float m_fin, float inv_l, int tl, LAS char* lds) {
  const int lane = tid & 63, r32 = lane & 31, hi = lane >> 5;
  LAS int* imp = (LAS int*)(lds + LDS_IMP) + tl * 65;
  const float NINF = -__builtin_inff();
  Stage st;
  stage_load(tid, st, Kg, 128, Kg, 128, 0); stage_write(tid, st, lds, 0); __syncthreads();
  for (int it = 0; it < ntiles; ++it) {
    const int key0 = it * 64, buf = it & 1;
    if (it + 1 < ntiles) stage_load(tid, st, Kg, 128, Kg, 128, key0 + 64);
    const int hh = khi - key0;
    if (__any(hh >= 0)) {
      f32x16 p0, p1; qkt(p0, p1, lds + LDS_K0 + buf * KBUF, qs, r32, hi);
#pragma unroll
      for (int r = 0; r < 16; ++r) { const int kk = crow(r, hi);
        p0[r] = kk <= hh ? __builtin_amdgcn_exp2f(fmaf(p0[r], QK_C, -m_fin)) * inv_l : 0.f;
        p1[r] = (kk + 32) <= hh ? __builtin_amdgcn_exp2f(fmaf(p1[r], QK_C, -m_fin)) * inv_l : 0.f; }
#pragma unroll
      for (int q = 0; q < 4; ++q) {
        const float a0 = (p0[4 * q] + p0[4 * q + 1]) + (p0[4 * q + 2] + p0[4 * q + 3]), a1 = (p1[4 * q] + p1[4 * q + 1]) + (p1[4 * q + 2] + p1[4 * q + 3]);
        const int g0 = 16 * it + 2 * q + hi, g1 = g0 + 8;
        LADD(imp + g0, (int)(a0 * 67108864.0f + 0.5f)); LADD(imp + g1, (int)(a1 * 67108864.0f + 0.5f));
        LADD(imp + g0 + 1, (int)(p0[4 * q + 3] * 67108864.0f + 0.5f));
        if (g1 + 1 < 64) LADD(imp + g1 + 1, (int)(p1[4 * q + 3] * 67108864.0f + 0.5f));
      }
    }
    if (it + 1 < ntiles) stage_write(tid, st, lds, buf ^ 1);
    __syncthreads();
  }
  (void)NINF;
}
DI void sb_pass(int tid, const bf16_t* Kg, int ldk, const bf16_t* Vg, int ldv, int tile_hi, LAS char* qs, int t, f32x16 (&o)[4], LAS char* lds) {
  const int lane = tid & 63, w = __builtin_amdgcn_readfirstlane(tid >> 6), r32 = lane & 31, hi = lane >> 5;
  LAS int* flags = (LAS int*)(lds + LDS_MISC);
  const float NINF = -__builtin_inff();
  float carry = 0.f;
  Stage st;
  stage_load(tid, st, Kg, ldk, Vg, ldv, tile_hi * 64); stage_write(tid, st, lds, 0); __syncthreads();
  for (int it = 0;; ++it) {
    const int tile = tile_hi - it, key0 = tile * 64, buf = it & 1;
    const bool more = tile > 0;
    if (more) stage_load(tid, st, Kg, ldk, Vg, ldv, key0 - 64);
    const int hh = t - 1 - key0;
    if (__any(hh >= 0)) {
      f32x16 p0, p1; qkt(p0, p1, lds + LDS_K0 + buf * KBUF, qs, r32, hi);
      float l0[16], l1[16];
#pragma unroll
      for (int r = 0; r < 16; ++r) { const int kk = crow(r, hi);
        { const float Z = p0[r] * QK_C; const float sp = fmaxf(Z, 0.f) + __builtin_amdgcn_logf(1.0f + __builtin_amdgcn_exp2f(-fabsf(Z))); const bool v = kk <= hh; l0[r] = v ? -sp : 0.f; p0[r] = v ? Z - sp : NINF; }
        { const float Z = p1[r] * QK_C; const float sp = fmaxf(Z, 0.f) + __builtin_amdgcn_logf(1.0f + __builtin_amdgcn_exp2f(-fabsf(Z))); const bool v = (kk + 32) <= hh; l1[r] = v ? -sp : 0.f; p1[r] = v ? Z - sp : NINF; } }
      float run = 0.f;
#pragma unroll
      for (int q = 3; q >= 0; --q) { const float A = (l1[4 * q] + l1[4 * q + 1]) + (l1[4 * q + 2] + l1[4 * q + 3]); const float Ap = __shfl_xor(A, 32, 64);
        const float T = carry + run + (hi == 0 ? Ap : 0.f);
        const float e2 = l1[4 * q + 3], e1 = e2 + l1[4 * q + 2], e0 = e1 + l1[4 * q + 1];
        p1[4 * q + 3] = __builtin_amdgcn_exp2f(p1[4 * q + 3] + T); p1[4 * q + 2] = __builtin_amdgcn_exp2f(p1[4 * q + 2] + T + e2);
        p1[4 * q + 1] = __builtin_amdgcn_exp2f(p1[4 * q + 1] + T + e1); p1[4 * q] = __builtin_amdgcn_exp2f(p1[4 * q] + T + e0);
        run += A + Ap; }
#pragma unroll
      for (int q = 3; q >= 0; --q) { const float A = (l0[4 * q] + l0[4 * q + 1]) + (l0[4 * q + 2] + l0[4 * q + 3]); const float Ap = __shfl_xor(A, 32, 64);
        const float T = carry + run + (hi == 0 ? Ap : 0.f);
        const float e2 = l0[4 * q + 3], e1 = e2 + l0[4 * q + 2], e0 = e1 + l0[4 * q + 1];
        p0[4 * q + 3] = __builtin_amdgcn_exp2f(p0[4 * q + 3] + T); p0[4 * q + 2] = __builtin_amdgcn_exp2f(p0[4 * q + 2] + T + e2);
        p0[4 * q + 1] = __builtin_amdgcn_exp2f(p0[4 * q + 1] + T + e1); p0[4 * q] = __builtin_amdgcn_exp2f(p0[4 * q] + T + e0);
        run += A + Ap; }
      carry += run;
      pv(o, lds + LDS_V0 + buf * VBUF, p0, p1, lane);
    }
    const int wdone = __all(carry < -150.0f) ? 1 : 0;
    if (lane == 0) flags[(it & 1) * 8 + w] = wdone;
    if (more) stage_write(tid, st, lds, buf ^ 1);
    __syncthreads();
    int alld = 1;
#pragma unroll
    for (int i = 0; i < 8; ++i) alld &= flags[(it & 1) * 8 + i];
    if (!more || alld) break;
  }
  __syncthreads();
}

DI int next_item(int* counter, LAS char* lds) {
  LAS int* slot = (LAS int*)(lds + LDS_MISC + 128);
  if (threadIdx.x == 0) *slot = atomicAdd(counter, 1);
  __syncthreads(); const int v = __builtin_amdgcn_readfirstlane(*slot); __syncthreads(); return v;
}
DI void zero_o(f32x16 (&o)[4]) {
#pragma unroll
  for (int db = 0; db < 4; ++db)
#pragma unroll
    for (int r = 0; r < 16; ++r) o[db][r] = 0.f;
}
#define ST_NEXT(ptr) do { (ptr) += 2048; asm volatile("" : "+v"(ptr)); } while (0)
DI void stash_set(float* st, const f32x16 (&o)[4], float sc) {
#pragma unroll
  for (int db = 0; db < 4; ++db)
#pragma unroll
    for (int q4 = 0; q4 < 4; ++q4) { f32x4 v = {o[db][4 * q4] * sc, o[db][4 * q4 + 1] * sc, o[db][4 * q4 + 2] * sc, o[db][4 * q4 + 3] * sc}; *(f32x4*)st = v; ST_NEXT(st); }
}
DI void stash_add(float* st, const f32x16 (&o)[4], float sc) {
#pragma unroll
  for (int db = 0; db < 4; ++db)
#pragma unroll
    for (int q4 = 0; q4 < 4; ++q4) { f32x4 v = *(const f32x4*)st; v[0] += o[db][4 * q4] * sc; v[1] += o[db][4 * q4 + 1] * sc; v[2] += o[db][4 * q4 + 2] * sc; v[3] += o[db][4 * q4 + 3] * sc; *(f32x4*)st = v; ST_NEXT(st); }
}
DI void nsa_item(const Params& p, int item, LAS char* lds, float* stash) {
  const int tid = otid(), w = __builtin_amdgcn_readfirstlane(tid >> 6), lane = tid & 63, r32 = lane & 31, hi = lane >> 5;
  const int jc = 63 - (item >> 2), b = (item >> 1) & 1, hk = item & 1, g = w & 3, qh = w >> 2;
  const int t0 = jc * 64, tl = 32 * qh + r32, t = t0 + tl, head = hk * 4 + g; const size_t row = (size_t)b * SEQ + t;
  const bf16_t* H0 = (const bf16_t*)(p.ws + OFF_E);
  const bf16_t* Qraw = (const bf16_t*)(p.ws + OFF_QRAW);
  const bf16_t* Kc = (const bf16_t*)(p.ws + OFF_KCMP) + (size_t)(b * 2 + hk) * 256 * 128; const bf16_t* Vc = (const bf16_t*)(p.ws + OFF_VCMP) + (size_t)(b * 2 + hk) * 256 * 128;
  bf16_t* Ocat = (bf16_t*)(p.ws + OFF_A);
  float* st = stash + (size_t)blockIdx.x * 32768 + tid * 4;
  const bf16_t* gap = HBLK(H0, NB0, b, 60) + (size_t)t * 128 + head * 3;
  const float g0 = sigmoid_f(bf_lo((unsigned)gap[0])), g1 = sigmoid_f(bf_lo((unsigned)gap[1])), g2 = sigmoid_f(bf_lo((unsigned)gap[2]));
  LAS int* imp = (LAS int*)(lds + LDS_IMP); LAS unsigned* msk = (LAS unsigned*)(lds + LDS_MASK);
  for (int i = tid; i < 64 * 65; i += 512) imp[i] = 0;
  if (tid < 128) msk[tid] = 0u;
  LAS char* qs = lds + LDS_Q + w * 8192 + lane * 16; f32x16 o[4]; float m_run, l_run;
  load_q(qs, Qraw + row * 1024 + head * 128 + 8 * hi);
  const int nmax = t >= 31 ? (t - 31) >> 4 : -1;
  const int ncm = (((t0 + 63 - 31) >> 4) >> 6) + 1;
  zero_o(o); m_run = -1e30f; l_run = 0.f;
  flash_pass(tid, Kc, 128, Vc, 128, 0, ncm, qs, 0, nmax, ~0ull, o, m_run, l_run, lds);
  { const float lt = pair_sum(l_run), inv = lt > 0.f ? 1.0f / lt : 0.f; stash_set(st, o, inv * g0);
    if (jc >= 16) cmp_importance(tid, Kc, ncm, qs, nmax, m_run, inv, tl, lds); }
  unsigned long long sel = ~0ull;
  if (jc >= 16) {
    __syncthreads();
#pragma unroll 1
    for (int qi = 0; qi < 8; ++qi) { const int q = 8 * w + qi, j = lane;
      const bool forced = j == 0 || j == jc || j == jc - 1; const int sc = forced ? 0x7fffffff : (j <= jc ? imp[q * 65 + j] : -1);
      int rank = 0;
#pragma unroll
      for (int j2 = 0; j2 < 64; ++j2) { const int s2 = __builtin_amdgcn_readlane(sc, j2); rank += (s2 > sc || (s2 == sc && j2 < j)) ? 1 : 0; }
      const unsigned long long m = __ballot(rank < 16 && j <= jc);
      if (lane == 0) { msk[2 * q] = (unsigned)m; msk[2 * q + 1] = (unsigned)(m >> 32); } }
    __syncthreads();
    sel = (unsigned long long)msk[2 * tl] | ((unsigned long long)msk[2 * tl + 1] << 32);
  }
  load_q(qs, HBLK(H0, NB0, b, head) + (size_t)t * 128 + 8 * hi);
  zero_o(o); m_run = -1e30f; l_run = 0.f;
  flash_pass(tid, HBLK(H0, NB0, b, 12 + hk), 128, HBLK(H0, NB0, b, 14 + hk), 128, 0, jc + 1, qs, 0, t, sel, o, m_run, l_run, lds);
  { const float lt = pair_sum(l_run), inv = lt > 0.f ? 1.0f / lt : 0.f; stash_add(st, o, inv * g1); }
  const int wt0 = jc >= 8 ? jc - 8 : 0;
  zero_o(o); m_run = -1e30f; l_run = 0.f;
  flash_pass(tid, HBLK(H0, NB0, b, 16 + hk), 128, HBLK(H0, NB0, b, 18 + hk), 128, wt0, jc - wt0 + 1, qs, t - 511, t, ~0ull, o, m_run, l_run, lds);
  { const float lt = pair_sum(l_run), inv = (lt > 0.f ? 1.0f / lt : 0.f) * g2;
    const bf16_t* gate = HBLK(H0, NB0, b, 20 + head) + (size_t)t * 128; bf16_t* dst = Ocat + row * DM + head * 128; const float* stp = st;
#pragma unroll
    for (int db = 0; db < 4; ++db)
#pragma unroll
      for (int q4 = 0; q4 < 4; ++q4) { const int d = 32 * db + 8 * q4 + 4 * hi; const u32x2 gv = *(const u32x2*)(gate + d); float v[4];
        const f32x4 sv = *(const f32x4*)stp; ST_NEXT(stp);
#pragma unroll
        for (int i = 0; i < 4; ++i) v[i] = sv[i] + o[db][4 * q4 + i] * inv;
        u32x2 ov; ov.x = cvt2(v[0] * silu_f(bf_lo(gv.x)), v[1] * silu_f(bf_hi(gv.x))); ov.y = cvt2(v[2] * silu_f(bf_lo(gv.y)), v[3] * silu_f(bf_hi(gv.y)));
        *(u32x2*)(dst + d) = ov; } }
}
DI void sb_item(const Params& p, int idx, LAS char* lds) {
  const int tid = otid(), w = __builtin_amdgcn_readfirstlane(tid >> 6), lane = tid & 63, r32 = lane & 31, hi = lane >> 5;
  const int qb = 15 - (idx >> 4), b = (idx >> 3) & 1, h = idx & 7, t = 256 * qb + 32 * w + r32; const size_t row = (size_t)b * SEQ + t;
  const bf16_t* H0 = (const bf16_t*)(p.ws + OFF_E); bf16_t* Ocat = (bf16_t*)(p.ws + OFF_A);
  LAS char* qs = lds + LDS_Q + w * 8192 + lane * 16; f32x16 o[4]; load_q(qs, HBLK(H0, NB0, b, 28 + h) + (size_t)t * 128 + 8 * hi); zero_o(o);
  sb_pass(tid, HBLK(H0, NB0, b, 36 + h), 128, HBLK(H0, NB0, b, 44 + h), 128, 4 * qb + 3, qs, t, o, lds);
  const bf16_t* gate = HBLK(H0, NB0, b, 52 + h) + (size_t)t * 128; bf16_t* dst = Ocat + row * DM + 1024 + h * 128;
#pragma unroll
  for (int db = 0; db < 4; ++db)
#pragma unroll
    for (int q4 = 0; q4 < 4; ++q4) { const int d = 32 * db + 8 * q4 + 4 * hi; const u32x2 gv = *(const u32x2*)(gate + d);
      u32x2 ov; ov.x = cvt2(o[db][4 * q4] * silu_f(bf_lo(gv.x)), o[db][4 * q4 + 1] * silu_f(bf_hi(gv.x))); ov.y = cvt2(o[db][4 * q4 + 2] * silu_f(bf_lo(gv.y)), o[db][4 * q4 + 3] * silu_f(bf_hi(gv.y)));
      *(u32x2*)(dst + d) = ov; }
}
DI void diff_item(const Params& p, int item, LAS char* lds, float lam) {
  const int tid = otid(), w = __builtin_amdgcn_readfirstlane(tid >> 6), lane = tid & 63, r32 = lane & 31, hi = lane >> 5;
  const int qb = 31 - (item >> 4), b = (item >> 3) & 1, h = item & 7, c = w >> 2, t = 128 * qb + 32 * (w & 3) + r32; const size_t row = (size_t)b * SEQ + t;
  const bf16_t* H1 = (const bf16_t*)(p.ws + OFF_E);
  LAS char* qs = lds + LDS_Q + w * 8192 + lane * 16; f32x16 o[8]; float m_run = -1e30f, l_run = 0.f;
#pragma unroll
  for (int db = 0; db < 8; ++db)
#pragma unroll
    for (int r = 0; r < 16; ++r) o[db][r] = 0.f;
  load_q(qs, HBLK(H1, NB1, b, 2 * h + c) + (size_t)t * 128 + 8 * hi);
  flash256c_pass(tid, HBLK(H1, NB1, b, 16 + 2 * h), HBLK(H1, NB1, b, 17 + 2 * h), HBLK(H1, NB1, b, 32 + 2 * h), 4 * qb + 4, qs, t, o, m_run, l_run, lds);
  const float lt = pair_sum(l_run), inv = lt > 0.f ? 1.0f / lt : 0.f;
  LAS char* X = lds + (tid & 255) * 8;
  if (c == 1) {
    const float sc = inv * lam;
#pragma unroll
    for (int db = 0; db < 8; ++db)
#pragma unroll
      for (int q4 = 0; q4 < 4; ++q4) { u32x2 ov; ov.x = cvt2(o[db][4 * q4] * sc, o[db][4 * q4 + 1] * sc); ov.y = cvt2(o[db][4 * q4 + 2] * sc, o[db][4 * q4 + 3] * sc); *(LAS u32x2*)(X + (db * 4 + q4) * 2048) = ov; }
  }
  __syncthreads();
  if (c == 0) {
    float sq = 0.f;
#pragma unroll
    for (int db = 0; db < 8; ++db)
#pragma unroll
      for (int q4 = 0; q4 < 4; ++q4) { const u32x2 x1 = *(LAS u32x2*)(X + (db * 4 + q4) * 2048);
        o[db][4 * q4] = o[db][4 * q4] * inv - bf_lo(x1.x); o[db][4 * q4 + 1] = o[db][4 * q4 + 1] * inv - bf_hi(x1.x); o[db][4 * q4 + 2] = o[db][4 * q4 + 2] * inv - bf_lo(x1.y); o[db][4 * q4 + 3] = o[db][4 * q4 + 3] * inv - bf_hi(x1.y);
        sq += (o[db][4 * q4] * o[db][4 * q4] + o[db][4 * q4 + 1] * o[db][4 * q4 + 1]) + (o[db][4 * q4 + 2] * o[db][4 * q4 + 2] + o[db][4 * q4 + 3] * o[db][4 * q4 + 3]); }
    const float r = __builtin_amdgcn_rsqf(pair_sum(sq) * (1.0f / 256.0f) + 1e-5f) * (1.0f - LAMBDA_INIT);
    bf16_t* dst = (bf16_t*)(p.ws + OFF_A) + row * DM + h * 256;
#pragma unroll
    for (int db = 0; db < 8; ++db)
#pragma unroll
      for (int q4 = 0; q4 < 4; ++q4) { const int d = 32 * db + 8 * q4 + 4 * hi;
        const u32x2 gv = *(const u32x2*)(HBLK(H1, NB1, b, 48 + 2 * h + (db >> 2)) + (size_t)t * 128 + (d & 127)); const f32x4 gn = *(const f32x4*)(p.od_gn_g + h * 256 + d);
        u32x2 ov; ov.x = cvt2(o[db][4 * q4] * r * gn[0] * silu_f(bf_lo(gv.x)), o[db][4 * q4 + 1] * r * gn[1] * silu_f(bf_hi(gv.x)));
        ov.y = cvt2(o[db][4 * q4 + 2] * r * gn[2] * silu_f(bf_lo(gv.y)), o[db][4 * q4 + 3] * r * gn[3] * silu_f(bf_hi(gv.y))); *(u32x2*)(dst + d) = ov; }
  }
  __syncthreads();
}

#define XB_TMO      128
#define XB_XCNT(j)  (256  + 64 * (j))
#define XB_XSUB(j)  (1280 + 64 * (j))
#define XB_XGEN(j)  (2304 + 64 * (j))
#define XB_TOP      3328
#define XB_TOPGEN   3392
#define XCD_BAR_WORDS 3456
#define XB_SPIN_CAP (1u << 18)
DI unsigned xb_ld(unsigned* p)              { return __hip_atomic_load(p, __ATOMIC_RELAXED, __HIP_MEMORY_SCOPE_AGENT); }
DI unsigned xb_add(unsigned* p, unsigned v) { return __hip_atomic_fetch_add(p, v, __ATOMIC_RELAXED, __HIP_MEMORY_SCOPE_AGENT); }
DI unsigned xb_xcc_id() { return (unsigned)__builtin_amdgcn_s_getreg((3 << 11) | 20) & 0xFu; }
#define XB_SPIN(cond, bar) do { unsigned _sp = 0; while (cond) { __builtin_amdgcn_s_sleep(1); \
    if ((++_sp & 255u) == 0u) { if (xb_ld(&(bar)[XB_TMO])) break; if (_sp > XB_SPIN_CAP) { atomicAdd(&(bar)[XB_TMO], 1u); break; } } } } while (0)
struct XcdBarrier { unsigned* bar; unsigned x; volatile LAS unsigned* st; };
DI XcdBarrier xcd_barrier_post(unsigned* bar, volatile LAS unsigned* st) {
    XcdBarrier b; b.bar = bar; b.x = xb_xcc_id(); b.st = st;
    if (threadIdx.x == 0) (void)xb_add(&bar[XB_XCNT(b.x)], 1u);
    return b;
}
DI void xcd_barrier_complete(unsigned* bar, unsigned x, unsigned& nloc, unsigned& nx) {
    const unsigned G = gridDim.x * gridDim.y * gridDim.z;
    unsigned sum, cntx, mine, sp = 0u;
    for (;;) {
        sum = 0u; cntx = 0u; mine = 0u;
#pragma unroll
        for (unsigned j = 0; j < 16; ++j) { const unsigned c = xb_ld(&bar[XB_XCNT(j)]); sum += c; cntx += (c > 0u) ? 1u : 0u; mine = (j == x) ? c : mine; }
        if (sum == G) break;
        __builtin_amdgcn_s_sleep(1);
        if ((++sp & 255u) == 0u) { if (xb_ld(&bar[XB_TMO])) break; if (sp > XB_SPIN_CAP) { atomicAdd(&bar[XB_TMO], 1u); break; } }
    }
    nloc = mine > 0u ? mine : 1u; nx = cntx > 0u ? cntx : 1u;
}
DI void xcd_barrier(const XcdBarrier& b) {
    asm volatile("s_waitcnt vmcnt(0)" ::: "memory");
    __syncthreads();
    if (threadIdx.x == 0) {
        unsigned* bar = b.bar;
        __builtin_amdgcn_s_waitcnt(0);
        unsigned nloc = b.st[0], nx = b.st[1];
        if (nloc == 0u) { xcd_barrier_complete(bar, b.x, nloc, nx); b.st[0] = nloc; b.st[1] = nx; }
        const unsigned old = xb_add(&bar[XB_XSUB(b.x)], 1u);
        const unsigned gen = old / nloc;
        if (old + 1u == (gen + 1u) * nloc) {
            __builtin_amdgcn_fence(__ATOMIC_RELEASE, "agent");
            asm volatile("s_waitcnt vmcnt(0)" ::: "memory");
            const unsigned og = xb_add(&bar[XB_TOP], 1u);
            const unsigned tg = og / nx;
            if (og + 1u == (tg + 1u) * nx) xb_add(&bar[XB_TOPGEN], 1u);
            else XB_SPIN(xb_ld(&bar[XB_TOPGEN]) == tg, bar);
            __builtin_amdgcn_fence(__ATOMIC_ACQUIRE, "agent");
            xb_add(&bar[XB_XGEN(b.x)], 1u);
            asm volatile("s_waitcnt vmcnt(0)" ::: "memory");
        } else {
            XB_SPIN(xb_ld(&bar[XB_XGEN(b.x)]) == gen, bar);
            __builtin_amdgcn_fence(__ATOMIC_ACQUIRE, "agent");
            asm volatile("s_waitcnt vmcnt(0)" ::: "memory");
        }
    }
    __syncthreads();
}

__global__ void __launch_bounds__(512) mega(Params p) {
  extern __shared__ __attribute__((aligned(16))) unsigned char shm[];
  LAS char* lds = (LAS char*)shm;
  cg::grid_group grid = cg::this_grid();
  const int bid = blockIdx.x, nb = gridDim.x;
  char* ws = p.ws;
  if (ws == nullptr) grid.sync();
  volatile LAS unsigned* xst = (volatile LAS unsigned*)(lds + LDS_XB);
  if (threadIdx.x == 0) { xst[0] = 0u; xst[1] = 0u; }
  __syncthreads();
  const XcdBarrier xbar = xcd_barrier_post((unsigned*)(ws + OFF_BAR), xst);
#define Xb ((bf16_t*)(ws + OFF_A))
#define cosT ((float*)(ws + OFF_COS))
#define sinT ((float*)(ws + OFF_SIN))
#define cnt ((int*)(ws + OFF_CNT))
#define lamp ((float*)(ws + OFF_CNT + 64))
#define PHASE_IDS int tid = threadIdx.x; asm volatile("" : "+v"(tid)); const size_t gtid = (size_t)bid * 512 + tid, gsz = (size_t)nb * 512; (void)gtid; (void)gsz;

  for (int rep0 = 0; rep0 < REP_P0; ++rep0) { PHASE_IDS
    for (size_t i = gtid; i < (size_t)NTOK * DM / 8; i += gsz) { const f32x4 a = ((const f32x4*)p.x)[2 * i], c = ((const f32x4*)p.x)[2 * i + 1];
      u32x4 w; w.x = cvt2(a[0], a[1]); w.y = cvt2(a[2], a[3]); w.z = cvt2(c[0], c[1]); w.w = cvt2(c[2], c[3]); ((u32x4*)Xb)[i] = w; }
    for (size_t i = gtid; i < (size_t)SEQ * 64; i += gsz) { const int t = (int)(i >> 6), f = (int)(i & 63);
      const float inv = (float)exp2(-(double)f * (13.287712379549449 / 64.0));
      const float ang = (float)t * inv; double rev = (double)ang * 0.15915494309189535; rev -= floor(rev); const float rf = (float)rev;
      cosT[i] = __builtin_amdgcn_cosf(rf); sinT[i] = __builtin_amdgcn_sinf(rf); }
    if (gtid == 0) { for (int i = 0; i < 8; ++i) cnt[i] = 0; float s1 = 0.f, s2 = 0.f; for (int i = 0; i < 128; ++i) { s1 += p.od_lq1[i] * p.od_lk1[i]; s2 += p.od_lq2[i] * p.od_lk2[i]; }
      lamp[0] = __expf(s1) - __expf(s2) + LAMBDA_INIT; }
    int base = 0; LAS float* tl = (LAS float*)lds;
    tr_matrix(p.ev_w_in, EV_IN, DM, N0, 1, (bf16_t*)(ws + OFF_B), base, bid, nb, tl);
    tr_matrix(p.ev_w1_k, 128, 4096, 128, 0, (bf16_t*)(ws + OFF_W1KT), base, bid, nb, tl);
    tr_matrix(p.ev_w1_v, 128, 4096, 128, 0, (bf16_t*)(ws + OFF_W1VT), base, bid, nb, tl);
    tr_matrix(p.ev_w2_k, 128, 128, 128, 3, (bf16_t*)(ws + OFF_W2KT), base, bid, nb, tl);
    tr_matrix(p.ev_w2_v, 128, 128, 128, 0, (bf16_t*)(ws + OFF_W2VT), base, bid, nb, tl);
  }
  xcd_barrier(xbar);
  { pg8::Gemm g{Xb, (const bf16_t*)(ws + OFF_B), NTOK, N0, DM}; pg8::StaticOrder S; S.init(NTOK, N0, nb, bid);
    pg8::EpiH E{(bf16_t*)(ws + OFF_E), NB0, (bf16_t*)(ws + OFF_QRAW), 1024, cosT, sinT, (1u << 6) | (1u << 8), 4, 4};
    for (int rep = 0; rep < REP_GEMM; ++rep) pg8::gemm_phase<pg8::EpiH, pg8::StaticOrder>((LAS unsigned char*)shm, g, S, E);
  }
  xcd_barrier(xbar);
  for (int rep2 = 0; rep2 < REP_P2; ++rep2)
  if (bid < 64) compress_block(p, bid, lds);
  xcd_barrier(xbar);
  for (int rep = 0; rep < REP_P3; ++rep) { if (rep) xcd_barrier(xbar);
  for (;;) { const int item = next_item(cnt + 2 * rep, lds); if (item >= 512 + 192) break;
    if (item >= 512) {
      LAS float* tl = (LAS float*)lds;
      for (int u = 0; u < 8; ++u) { const int ti = (item - 512) * 8 + u;
        if (ti < 1024) transpose_tile(p.od_w_in, N1, DM, 2, (bf16_t*)(ws + OFF_B), (ti >> 4) * 128, (ti & 15) * 128, tl);
        else if (ti < 1280) transpose_tile(p.od_w_out, DM, DM, 0, (bf16_t*)(ws + OFF_BTO1), ((ti - 1024) >> 4) * 128, ((ti - 1024) & 15) * 128, tl);
        else transpose_tile(p.ev_w_out, DM, DM, 0, (bf16_t*)(ws + OFF_BTO0), ((ti - 1280) >> 4) * 128, ((ti - 1280) & 15) * 128, tl); }
      continue; }
#ifndef SKIP_NSA
    if (item < 256) nsa_item(p, item, lds, p.out);
#endif
#ifndef SKIP_SB
    if (item >= 256) sb_item(p, item - 256, lds);
#endif
  } }
  xcd_barrier(xbar);
  { pg8::Gemm g{(const bf16_t*)(ws + OFF_A), (const bf16_t*)(ws + OFF_BTO0), NTOK, DM, DM}; pg8::StaticOrder S; S.init(NTOK, DM, nb, bid);
    pg8::EpiRes E{p.out, p.x, DM};
    for (int rep = 0; rep < REP_GEMM; ++rep) pg8::gemm_phase<pg8::EpiRes, pg8::StaticOrder>((LAS unsigned char*)shm, g, S, E);
  }
  xcd_barrier(xbar);
  for (int r = 0; r < REP_LN; ++r) ln_phase(p.out, p.ev_ln_g, p.ev_ln_b, nullptr, (bf16_t*)(ws + OFF_A), (float*)(ws + OFF_SSQ));
  for (int r = 0; r < REP_SYNC; ++r) xcd_barrier(xbar);
  xcd_barrier(xbar);
  { pg8::Gemm g{(const bf16_t*)(ws + OFF_A), (const bf16_t*)(ws + OFF_B), NTOK, N1, DM}; pg8::StaticOrder S; S.init(NTOK, N1, nb, bid);
    pg8::EpiH E{(bf16_t*)(ws + OFF_E), NB1, nullptr, 0, cosT, sinT, 0u, 16, 0};
    for (int rep = 0; rep < REP_GEMM; ++rep) pg8::gemm_phase<pg8::EpiH, pg8::StaticOrder>((LAS unsigned char*)shm, g, S, E);
  }
  xcd_barrier(xbar);
  { const float lam = __uint_as_float(__builtin_amdgcn_readfirstlane(__float_as_uint(lamp[0])));
    for (;;) { const int item = next_item(cnt + 1, lds); if (item >= 512) break; diff_item(p, item, lds, lam); } }
  xcd_barrier(xbar);
  { pg8::Gemm g{(const bf16_t*)(ws + OFF_A), (const bf16_t*)(ws + OFF_BTO1), NTOK, DM, DM}; pg8::StaticOrder S; S.init(NTOK, DM, nb, bid);
    pg8::EpiRes1 E{(float*)(ws + OFF_E), p.out, (const float*)(ws + OFF_SSQ), p.ev_ln_g, p.ev_ln_b, DM};
    for (int rep = 0; rep < REP_GEMM; ++rep) pg8::gemm_phase<pg8::EpiRes1, pg8::StaticOrder>((LAS unsigned char*)shm, g, S, E);
  }
  xcd_barrier(xbar);
  for (int r = 0; r < REP_LN; ++r) ln_phase((const float*)(ws + OFF_E), p.od_ln_g, p.od_ln_b, p.out, nullptr, nullptr);
}

extern "C" void kernel_launch(void* const* d_in, const int* in_sizes, int n_in, void* d_out, int out_size, void* d_ws, size_t ws_size, hipStream_t stream) {
  constexpr size_t kDynLds = 156672 + 16;
  static int grid_blocks = 0;
  if (!grid_blocks) {
    int dev = 0, cus = 0, per_cu = 0;
    (void)hipGetDevice(&dev);
    (void)hipDeviceGetAttribute(&cus, hipDeviceAttributeMultiprocessorCount, dev);
    (void)hipFuncSetAttribute((const void*)mega, hipFuncAttributeMaxDynamicSharedMemorySize, (int)kDynLds);
    (void)hipOccupancyMaxActiveBlocksPerMultiprocessor(&per_cu, mega, 512, kDynLds);
    if (per_cu < 1) fprintf(stderr, "occupancy query says 0 blocks per CU\n");
    if (ws_size < WS_NEED) fprintf(stderr, "workspace too small: %zu < %zu\n", ws_size, WS_NEED);
    grid_blocks = cus < 256 ? cus : 256;
  }
  Params p{};
  const float* const* in = (const float* const*)d_in;
  p.x = in[0]; p.ev_w_in = in[1]; p.ev_pe_k = in[2]; p.ev_pe_v = in[3]; p.ev_w1_k = in[4]; p.ev_w2_k = in[5]; p.ev_w1_v = in[6]; p.ev_w2_v = in[7];
  p.ev_w_out = in[8]; p.ev_ln_g = in[9]; p.ev_ln_b = in[10]; p.od_w_in = in[11]; p.od_lq1 = in[12]; p.od_lk1 = in[13]; p.od_lq2 = in[14]; p.od_lk2 = in[15];
  p.od_gn_g = in[16]; p.od_w_out = in[17]; p.od_ln_g = in[18]; p.od_ln_b = in[19]; p.out = (float*)d_out; p.ws = (char*)d_ws;
  (void)hipMemsetAsync((char*)d_ws + OFF_CNT, 0, 256 + XCD_BAR_WORDS * 4, stream);
  void* args[] = {&p};
  hipError_t e = hipLaunchCooperativeKernel((void*)mega, dim3(grid_blocks), dim3(512), args, kDynLds, stream);
  if (e != hipSuccess) fprintf(stderr, "cooperative launch failed: %s (grid %d)\n", hipGetErrorString(e), grid_blocks);
}
```
